# Optimizing an MI355X kernel written in HIP

```python
import jax, jax.numpy as jnp
from jax import lax
import numpy as np


D_MODEL = 1024
BATCH = 16
SEQ = 4096
DEPTH = 4

HEAD_DIM = 64
ROPE_THETA = 500000.0
ROT_DIM = HEAD_DIM // 4
NORM_EPS = 1e-6
BLOCK = 128

DSA_GROUPS = ((128, 1), (512, 4), (2048, 16))
DSA_HEADS_PER_GROUP = 4
DSA_HEADS = DSA_HEADS_PER_GROUP * len(DSA_GROUPS)
DSA_W = DSA_HEADS * HEAD_DIM
DSA_OUT = DSA_HEADS_PER_GROUP * HEAD_DIM

MLA_HEADS = 8
MLA_Q_LORA = 256
MLA_KV_LORA = 128
MLA_NOPE = 64
MLA_ROPE = 32
MLA_QK = MLA_NOPE + MLA_ROPE
MLA_V = 64
MLA_OUT = MLA_HEADS * MLA_V

SB_HEADS = 8
SB_W = SB_HEADS * HEAD_DIM
SB_OUT = SB_W

N_BRANCH = 3
D_FF = 4 * D_MODEL
BRANCH_IN = DSA_OUT + MLA_OUT + SB_OUT

_IN_SIZES = (DSA_W, DSA_W, DSA_W, MLA_Q_LORA, MLA_KV_LORA, MLA_ROPE, SB_W, SB_W, SB_W, N_BRANCH * D_MODEL)
IN_COLS = sum(_IN_SIZES)
IN_SPLITS = tuple(sum(_IN_SIZES[:i + 1]) for i in range(len(_IN_SIZES) - 1))

kernel_name = "hybrid_gated_dilated_mla_stickbreaking"


def _rms_norm(x, g):
    x32 = x.astype(jnp.float32)
    y = x32 * lax.rsqrt(jnp.mean(x32 * x32, axis=-1, keepdims=True) + NORM_EPS)
    return (y * g.astype(jnp.float32)).astype(x.dtype)


def _rope_tables(seq, dim):
    pos = jnp.arange(seq, dtype=jnp.float32)
    inv_freq = ROPE_THETA ** (-jnp.arange(0, dim, 2, dtype=jnp.float32) / dim)
    ang = pos[:, None] * inv_freq[None, :]
    return jnp.cos(ang), jnp.sin(ang)


def _apply_rope(x, cos, sin):
    half = x.shape[-1] // 2
    bshape = (cos.shape[0],) + (1,) * (x.ndim - 3) + (half,)
    c = cos.reshape(bshape)
    s = sin.reshape(bshape)
    x32 = x.astype(jnp.float32)
    x1, x2 = x32[..., :half], x32[..., half:]
    return jnp.concatenate([x1 * c - x2 * s, x2 * c + x1 * s], axis=-1).astype(x.dtype)


def _partial_rope(x, cos, sin):
    return jnp.concatenate([_apply_rope(x[..., :ROT_DIM], cos, sin), x[..., ROT_DIM:]], axis=-1)


def _strided_band_attention(q, k, v, window, dilation):
    B, S, H, Dh = q.shape
    span = window // dilation
    blk = span
    L = S // dilation
    nb = -(-L // blk)
    Lp = nb * blk

    def to_blocks(t):
        t = t.reshape(B, L, dilation, H, Dh).transpose(0, 2, 1, 3, 4)
        t = jnp.pad(t, ((0, 0), (0, 0), (0, Lp - L), (0, 0), (0, 0)))
        return t.reshape(B, dilation, nb, blk, H, Dh)

    def band(t):
        prev = jnp.pad(t, ((0, 0), (0, 0), (1, 0), (0, 0), (0, 0), (0, 0)))[:, :, :-1]
        return jnp.concatenate([prev, t], axis=3)

    qb = to_blocks(q)
    kband = band(to_blocks(k))
    vband = band(to_blocks(v))
    s = jnp.einsum('brnqhd,brnkhd->brnhqk', qb, kband,
                   preferred_element_type=jnp.float32) * (Dh ** -0.5)
    qi = jnp.arange(blk)[:, None]
    kj = jnp.arange(2 * blk)[None, :]
    dist = qi + blk - kj
    first = (jnp.arange(nb) == 0)[:, None, None]
    valid = (dist >= 0)[None] & (dist <= span)[None] & ~(first & (kj < blk)[None])
    s = jnp.where(valid[:, None], s, -jnp.inf)
    m = jnp.max(s, axis=-1, keepdims=True)
    p = jnp.exp(s - m)
    den = jnp.sum(p, axis=-1, keepdims=True)
    o = jnp.einsum('brnhqk,brnkhd->brnqhd', (p / den).astype(v.dtype), vband)
    lse = (m + jnp.log(den))[..., 0]
    o = o.reshape(B, dilation, Lp, H, Dh)[:, :, :L].transpose(0, 2, 1, 3, 4).reshape(B, S, H, Dh)
    lse = lse.transpose(0, 1, 2, 4, 3).reshape(B, dilation, Lp, H)[:, :, :L]
    lse = lse.transpose(0, 2, 1, 3).reshape(B, S, H)
    return o, lse


def _dilated_mixture(q, k, v):
    outs, lses = [], []
    for g, (window, dil) in enumerate(DSA_GROUPS):
        o, lse = _strided_band_attention(q[:, :, g], k[:, :, g], v[:, :, g], window, dil)
        outs.append(o)
        lses.append(lse)
    wts = jax.nn.softmax(jnp.stack(lses, axis=0), axis=0)
    o = jnp.sum(wts[..., None] * jnp.stack(outs, axis=0).astype(jnp.float32), axis=0)
    return o.astype(q.dtype)


def _causal_softmax_attention(q, k, v):
    B, S, H, Dq = q.shape
    nb = S // BLOCK
    qb = q.reshape(B, nb, BLOCK, H, Dq).transpose(1, 0, 2, 3, 4)
    kpos = jnp.arange(S)
    scale = Dq ** -0.5

    def one(args):
        qi, start = args
        s = jnp.einsum('bqhd,bkhd->bhqk', qi, k, preferred_element_type=jnp.float32) * scale
        qpos = start + jnp.arange(BLOCK)
        s = jnp.where(kpos[None, :] <= qpos[:, None], s, -jnp.inf)
        p = jax.nn.softmax(s, axis=-1)
        return jnp.einsum('bhqk,bkhd->bqhd', p.astype(v.dtype), v)

    out = lax.map(one, (qb, jnp.arange(nb) * BLOCK))
    return out.transpose(1, 0, 2, 3, 4).reshape(B, S, H, v.shape[-1])


def _stick_breaking_attention(q, k, v):
    B, S, H, Dh = q.shape
    nb = S // BLOCK
    qb = q.reshape(B, nb, BLOCK, H, Dh).transpose(1, 0, 2, 3, 4)
    kpos = jnp.arange(S)
    scale = Dh ** -0.5

    def one(args):
        qi, start = args
        z = jnp.einsum('bqhd,bkhd->bhqk', qi, k, preferred_element_type=jnp.float32) * scale
        qpos = start + jnp.arange(BLOCK)
        strict = kpos[None, :] < qpos[:, None]
        log_beta = jax.nn.log_sigmoid(z)
        log_one_minus = jnp.where(strict, jax.nn.log_sigmoid(-z), 0.0)
        after = lax.cumsum(log_one_minus, axis=3, reverse=True) - log_one_minus
        weights = jnp.exp(jnp.where(strict, log_beta + after, -jnp.inf))
        return jnp.einsum('bhqk,bkhd->bqhd', weights.astype(v.dtype), v)

    out = lax.map(one, (qb, jnp.arange(nb) * BLOCK))
    return out.transpose(1, 0, 2, 3, 4).reshape(B, S, H, Dh)


def setup_inputs(seed: int = 0) -> dict:
    key = jax.random.key(seed)
    ks = jax.random.split(key, 20)
    f32 = jnp.float32

    def dense(k, shape, fan_in):
        return jax.random.normal(k, shape, f32) * (fan_in ** -0.5)

    def gain(k, n):
        return 1.0 + 0.02 * jax.random.normal(k, (DEPTH, n), f32)

    w_branch = jnp.concatenate([
        dense(ks[11], (DEPTH, DSA_OUT, D_MODEL), DSA_OUT),
        dense(ks[12], (DEPTH, MLA_OUT, D_MODEL), MLA_OUT),
        dense(ks[13], (DEPTH, SB_OUT, D_MODEL), SB_OUT)], axis=1)
    return {
        'x': jax.random.normal(ks[0], (BATCH, SEQ, D_MODEL), f32),
        'attn_norm': gain(ks[1], D_MODEL),
        'w_in': dense(ks[2], (DEPTH, D_MODEL, IN_COLS), D_MODEL),
        'a_q_norm': gain(ks[3], HEAD_DIM),
        'a_k_norm': gain(ks[4], HEAD_DIM),
        'b_q_a_norm': gain(ks[5], MLA_Q_LORA),
        'w_q_b': dense(ks[6], (DEPTH, MLA_Q_LORA, MLA_HEADS, MLA_QK), MLA_Q_LORA),
        'b_kv_a_norm': gain(ks[7], MLA_KV_LORA),
        'w_kv_b': dense(ks[8], (DEPTH, MLA_KV_LORA, MLA_HEADS, MLA_NOPE + MLA_V), MLA_KV_LORA),
        'b_q_norm': gain(ks[9], MLA_QK),
        'b_k_norm': gain(ks[10], MLA_QK),
        'w_branch': w_branch,
        'w_out': dense(ks[14], (DEPTH, D_MODEL, D_MODEL), D_MODEL),
        'mlp_norm': gain(ks[15], D_MODEL),
        'w_ff1': dense(ks[16], (DEPTH, D_MODEL, D_FF), D_MODEL),
        'w_ff2': dense(ks[17], (DEPTH, D_FF, D_MODEL), D_FF),
    }


def reference(x, attn_norm, w_in, a_q_norm, a_k_norm, b_q_a_norm, w_q_b, b_kv_a_norm,
              w_kv_b, b_q_norm, b_k_norm, w_branch, w_out, mlp_norm, w_ff1, w_ff2):
    B, S, _ = x.shape
    cos_p, sin_p = _rope_tables(S, ROT_DIM)
    cos_m, sin_m = _rope_tables(S, MLA_ROPE)
    grp = (B, S, len(DSA_GROUPS), DSA_HEADS_PER_GROUP, HEAD_DIM)
    for l in range(DEPTH):
        h = _rms_norm(x, attn_norm[l])
        proj = h @ w_in[l]
        a_q, a_k, a_v, b_ql, b_kvl, b_kr, c_q, c_k, c_v, gate = jnp.split(proj, IN_SPLITS, axis=-1)

        aq = _partial_rope(_rms_norm(a_q.reshape(grp), a_q_norm[l]), cos_p, sin_p)
        ak = _partial_rope(_rms_norm(a_k.reshape(grp), a_k_norm[l]), cos_p, sin_p)
        o_a = _dilated_mixture(aq, ak, a_v.reshape(grp)).reshape(B, S, DSA_OUT)

        bq = jnp.einsum('bsr,rhe->bshe', _rms_norm(b_ql, b_q_a_norm[l]), w_q_b[l])
        kv = jnp.einsum('bsr,rhe->bshe', _rms_norm(b_kvl, b_kv_a_norm[l]), w_kv_b[l])
        k_nope, bv = kv[..., :MLA_NOPE], kv[..., MLA_NOPE:]
        k_rope = jnp.broadcast_to(b_kr[:, :, None, :], (B, S, MLA_HEADS, MLA_ROPE))
        bk = jnp.concatenate([k_nope, k_rope], axis=-1)
        bq = _rms_norm(bq, b_q_norm[l])
        bk = _rms_norm(bk, b_k_norm[l])
        bq = jnp.concatenate([bq[..., :MLA_NOPE], _apply_rope(bq[..., MLA_NOPE:], cos_m, sin_m)], axis=-1)
        bk = jnp.concatenate([bk[..., :MLA_NOPE], _apply_rope(bk[..., MLA_NOPE:], cos_m, sin_m)], axis=-1)
        o_b = _causal_softmax_attention(bq, bk, bv).reshape(B, S, MLA_OUT)

        sb = (B, S, SB_HEADS, HEAD_DIM)
        o_c = _stick_breaking_attention(c_q.reshape(sb), c_k.reshape(sb), c_v.reshape(sb)).reshape(B, S, SB_OUT)

        gates = jax.nn.sigmoid(gate.reshape(B, S, N_BRANCH, D_MODEL))
        wb = w_branch[l]
        merged = (gates[:, :, 0] * (o_a @ wb[:DSA_OUT])
                  + gates[:, :, 1] * (o_b @ wb[DSA_OUT:DSA_OUT + MLA_OUT])
                  + gates[:, :, 2] * (o_c @ wb[DSA_OUT + MLA_OUT:]))
        x = x + merged @ w_out[l]

        h2 = _rms_norm(x, mlp_norm[l])
        x = x + jnp.square(jax.nn.relu(h2 @ w_ff1[l])) @ w_ff2[l]
    return x
```

```cpp
#include <hip/hip_runtime.h>
#include <hip/hip_cooperative_groups.h>
#include <cstdio>
#include <cstdint>
#include <cmath>
namespace cg = cooperative_groups;
namespace pg8 {
#define PG8_LAS __attribute__((address_space(3)))
typedef unsigned short bf16_t;
typedef short bf16x8 __attribute__((ext_vector_type(8)));
typedef float f32x4 __attribute__((ext_vector_type(4)));
typedef unsigned u32x4 __attribute__((ext_vector_type(4)));
constexpr int BM = 256, BK = 64, HALF = 128, HTB = HALF * BK * 2  , STAGE_BYTES = 8 * HTB, NXCD = 8, WGM = 8;

__host__ __device__ __forceinline__ int lds_byte(int r, int c) { const int st = (r >> 4) * 2 + (c >> 5), rr = r & 15, cc = c & 31, ob = rr * 64 + cc * 2; return st * 1024 + (ob ^ (((ob >> 9) & 1) << 5)); }
__host__ __device__ __forceinline__ void stage_rc(int b, int& R, int& C) { const int st = b / 1024, sb = b % 1024, swz = sb ^ (((sb >> 9) & 1) << 5); R = (st >> 1) * 16 + swz / 64; C = (st & 1) * 32 + (swz % 64) / 2; }
__host__ __device__ __forceinline__ int perm32(int rho) { const int n = rho >> 4, i = rho & 15; return 8 * (i >> 2) + 4 * n + (i & 3); }

struct Unit { int pm, pn; };
struct Gemm { const bf16_t* A; const bf16_t* Bt; int M, N, K; int dil = 0; };

struct StaticOrder {
    int nM, nN, nwg, G, c;
    __host__ __device__ void init(int M, int N, int G_, int c_) { nM = M / BM; nN = N / BM; nwg = nM * nN; G = G_; c = c_; }
    __host__ __device__ bool next(int i, Unit& u) const {
        const long L = (long)i * G + c; if (L >= nwg) return false;
        int wgid = (int)L; { const int q = nwg / NXCD, r = nwg % NXCD, xcd = wgid % NXCD, off = wgid / NXCD; wgid = (xcd < r ? xcd * (q + 1) : r * (q + 1) + (xcd - r) * q) + off; }
        const int nig = WGM * nN, gid = wgid / nig, fm = gid * WGM, gsz = (nM - fm) < WGM ? (nM - fm) : WGM;
        u.pm = fm + ((wgid % nig) % gsz); u.pn = (wgid % nig) / gsz; return true;
    }
    __device__ __forceinline__ void a_ready(const Unit&) const {}
    __device__ __forceinline__ void done(const Unit&) const {}
};
__device__ __forceinline__ unsigned cvt_pk_bf16(float lo, float hi) { unsigned r; asm volatile("v_cvt_pk_bf16_f32 %0, %1, %2" : "=v"(r) : "v"(lo), "v"(hi)); return r; }
__device__ __forceinline__ const char* b_unit(const Gemm& g, const Unit& u, size_t tstep, int& bs) {
    bs = 1;
    if (g.dil != 0 && (u.pm == 1 || u.pm == 2)) {
        const int sh = (u.pm == 1) ? 2 : 4; bs = 1 << sh;
        const int j0 = u.pn * 256, b = j0 >> 12, jj = j0 & 4095, rc = jj >> (12 - sh), u0 = jj & ((4096 >> sh) - 1);
        return (const char*)g.Bt + (size_t)((b << 12) + (u0 << sh) + rc) * g.K * 2;
    }
    return (const char*)g.Bt + (size_t)u.pn * tstep;
}
template <class Epi, class Sched, bool ALIGN_EPI = false, bool SP2 = false>
__device__ __forceinline__ void gemm_phase(PG8_LAS unsigned char* lds, const Gemm g, const Sched& S, const Epi& E, const int tid_in) {
    const int tid = tid_in, wid = __builtin_amdgcn_readfirstlane(tid >> 6), lane = tid & 63, wr = wid >> 2, wc = wid & 3, fr = lane & 15, fq = lane >> 4;
    const int K = g.K, nt = K / BK;
    unsigned voffA[2], voffBr[2], voffBc[2];
#pragma unroll
    for (int i = 0; i < 2; ++i) { int R, C; stage_rc(tid * 16 + i * 8192, R, C); const int Rb = (Epi::PERM || E.perm_b()) ? ((R & ~31) + perm32(R & 31)) : R;
        voffA[i] = (unsigned)(R * K + C) * 2u; voffBr[i] = (unsigned)(Rb * K) * 2u; voffBc[i] = (unsigned)C * 2u; }
    const size_t kstep = (size_t)(BK * 2);
    const size_t hstep = (size_t)HALF * K * 2;
    const size_t tstep = 2 * hstep;
    const unsigned ldsw = (unsigned)wid * 1024u;
    const int aoff = lds_byte(wr * 64 + fr, fq * 8), boff = lds_byte(wc * 32 + fr, fq * 8);
#define PG8_SA(b, h) (((b) * 2 + (h)) * HTB)
#define PG8_SB(b, h) ((4 + (b) * 2 + (h)) * HTB)
#define PG8_STAGE(bufoff, gbase, voff) do { _Pragma("unroll") for (int _i = 0; _i < 2; ++_i) \
        __builtin_amdgcn_global_load_lds((const unsigned*)((const char*)(gbase) + (voff)[_i]), (PG8_LAS unsigned*)(lds + (bufoff) + ldsw + _i * 8192), 16, 0, 0); } while (0)
#define PG8_LDA(dst, b, h) do { _Pragma("unroll") for (int m = 0; m < 4; ++m) _Pragma("unroll") for (int k = 0; k < 2; ++k) dst[m][k] = *(const PG8_LAS bf16x8*)(lds + PG8_SA(b, h) + aoff + m * 2048 + k * 1024); } while (0)
#define PG8_LDB(dst, b, h) do { _Pragma("unroll") for (int n = 0; n < 2; ++n) _Pragma("unroll") for (int k = 0; k < 2; ++k) dst[n][k] = *(const PG8_LAS bf16x8*)(lds + PG8_SB(b, h) + boff + n * 2048 + k * 1024); } while (0)
#define PG8_MMA(ai, bj, At, Bt) do { __builtin_amdgcn_s_setprio(1); _Pragma("unroll") for (int m = 0; m < 4; ++m) _Pragma("unroll") for (int n = 0; n < 2; ++n) _Pragma("unroll") for (int k = 0; k < 2; ++k) \
        acc[ai][bj][m][n] = __builtin_amdgcn_mfma_f32_16x16x32_bf16(Bt[n][k], At[m][k], acc[ai][bj][m][n], 0, 0, 0); __builtin_amdgcn_s_setprio(0); } while (0)
#define PG8_WAIT_V(n) asm volatile("s_waitcnt vmcnt(" #n ")" ::: "memory")
#define PG8_WAIT_L(n) asm volatile("s_waitcnt lgkmcnt(" #n ")" ::: "memory")
#define PG8_BAR __builtin_amdgcn_s_barrier()
#define PG8_SCHED __builtin_amdgcn_sched_barrier(0)
    Unit cur, nxt; int ui = 0;
    if (!S.next(0, cur)) return;
    f32x4 acc[2][2][4][2];
#pragma unroll
    for (int a = 0; a < 2; ++a)
#pragma unroll
        for (int b = 0; b < 2; ++b)
#pragma unroll
            for (int m = 0; m < 4; ++m)
#pragma unroll
                for (int n = 0; n < 2; ++n) acc[a][b][m][n] = (f32x4){0.f, 0.f, 0.f, 0.f};
    bf16x8 At[4][2], B0[2][2], B1[2][2];
    const char* cA = (const char*)g.A + (size_t)cur.pm * tstep; int bsc; const char* cB = b_unit(g, cur, tstep, bsc);
    size_t hBc = hstep * (size_t)bsc;
    S.a_ready(cur);
    { const unsigned vBc[2] = {voffBr[0] * (unsigned)bsc + voffBc[0], voffBr[1] * (unsigned)bsc + voffBc[1]};
    if constexpr (SP2) {
        PG8_STAGE(PG8_SB(0, 0), cB, vBc); PG8_STAGE(PG8_SB(0, 1), cB + hBc, vBc); PG8_STAGE(PG8_SA(0, 0), cA, voffA); PG8_STAGE(PG8_SA(0, 1), cA + hstep, voffA);
        if (wr == 1) PG8_BAR;
        PG8_WAIT_V(2); PG8_BAR;
        PG8_STAGE(PG8_SB(1, 0), cB + kstep, vBc); PG8_STAGE(PG8_SA(1, 0), cA + kstep, voffA); PG8_STAGE(PG8_SB(1, 1), cB + hBc + kstep, vBc);
        PG8_WAIT_V(6); PG8_BAR;
    } else {
        PG8_STAGE(PG8_SB(0, 0), cB, vBc); PG8_STAGE(PG8_SA(0, 0), cA, voffA); PG8_STAGE(PG8_SB(0, 1), cB + hBc, vBc); PG8_STAGE(PG8_SA(0, 1), cA + hstep, voffA);
        if (wr == 1) PG8_BAR;
        PG8_WAIT_V(4); PG8_BAR;
        PG8_STAGE(PG8_SB(1, 0), cB + kstep, vBc); PG8_STAGE(PG8_SA(1, 0), cA + kstep, voffA); PG8_STAGE(PG8_SB(1, 1), cB + hBc + kstep, vBc);
        PG8_WAIT_V(6); PG8_BAR;
    }
    }
    for (;;) {
        const bool has_next = S.next(ui + 1, nxt);
        const char* nA = has_next ? (const char*)g.A + (size_t)nxt.pm * tstep : cA; int bsn = bsc; const char* nB = cB; if (has_next) nB = b_unit(g, nxt, tstep, bsn);
        const size_t hBn = hstep * (size_t)bsn;
        for (int t = 0; t < nt; t += 2) {
            if constexpr (Epi::HAS_MID) { if (E.mid_at(t)) { if (wr == 0) PG8_BAR; E.mid(acc, cur, wr, wc, fr, fq, t); if (wr == 1) PG8_BAR; } }
            const bool last = (t == nt - 2);
            const char* a1 = cA + (size_t)(t + 1) * kstep;
            const char* a2 = last ? nA : cA + (size_t)(t + 2) * kstep; const char* b2 = last ? nB : cB + (size_t)(t + 2) * kstep;
            const char* a3 = a2 + kstep; const char* b3 = b2 + kstep;
            const unsigned bsel = (unsigned)(last ? bsn : bsc); const unsigned vB[2] = {voffBr[0] * bsel + voffBc[0], voffBr[1] * bsel + voffBc[1]}; const size_t hB = last ? hBn : hBc;
            if (last && has_next) S.a_ready(nxt);
            if constexpr (SP2) {
            PG8_LDB(B0, 0, 0); PG8_LDB(B1, 0, 1); PG8_SCHED; PG8_LDA(At, 0, 0); PG8_STAGE(PG8_SA(1, 1), a1 + hstep, voffA);
            PG8_WAIT_V(8); PG8_WAIT_L(0); PG8_BAR; PG8_MMA(0, 0, At, B0); PG8_MMA(0, 1, At, B1); PG8_BAR; PG8_SCHED;
            PG8_LDA(At, 0, 1); PG8_STAGE(PG8_SB(0, 0), b2, vB); PG8_STAGE(PG8_SB(0, 1), b2 + hB, vB); PG8_STAGE(PG8_SA(0, 0), a2, voffA);
            PG8_WAIT_V(8); PG8_WAIT_L(0); PG8_BAR; PG8_MMA(1, 0, At, B0); PG8_MMA(1, 1, At, B1); PG8_BAR; PG8_SCHED;
            PG8_LDB(B0, 1, 0); PG8_LDB(B1, 1, 1); PG8_SCHED; PG8_LDA(At, 1, 0); PG8_STAGE(PG8_SA(0, 1), a2 + hstep, voffA);
            PG8_WAIT_V(8); PG8_WAIT_L(0); PG8_BAR; PG8_MMA(0, 0, At, B0); PG8_MMA(0, 1, At, B1); PG8_BAR; PG8_SCHED;
            PG8_LDA(At, 1, 1); PG8_STAGE(PG8_SB(1, 0), b3, vB); PG8_STAGE(PG8_SB(1, 1), b3 + hB, vB); PG8_STAGE(PG8_SA(1, 0), a3, voffA);
            PG8_WAIT_V(8); PG8_WAIT_L(0); PG8_BAR; PG8_MMA(1, 0, At, B0); PG8_MMA(1, 1, At, B1); PG8_BAR; PG8_SCHED;
            } else {
            PG8_LDB(B0, 0, 0); PG8_SCHED; PG8_LDA(At, 0, 0); PG8_STAGE(PG8_SA(1, 1), a1 + hstep, voffA);
            PG8_WAIT_L(8); PG8_BAR; PG8_WAIT_L(0); PG8_MMA(0, 0, At, B0); PG8_BAR; PG8_SCHED;
            PG8_LDB(B1, 0, 1); PG8_STAGE(PG8_SB(0, 0), b2, vB);
            PG8_BAR; PG8_WAIT_L(0); PG8_MMA(0, 1, At, B1); PG8_BAR;
            PG8_LDA(At, 0, 1); PG8_STAGE(PG8_SA(0, 0), a2, voffA);
            PG8_BAR; PG8_WAIT_L(0); PG8_MMA(1, 0, At, B0); PG8_BAR; PG8_SCHED;
            PG8_STAGE(PG8_SB(0, 1), b2 + hB, vB);
            PG8_WAIT_V(6); PG8_BAR; PG8_MMA(1, 1, At, B1); PG8_BAR;
            PG8_LDB(B0, 1, 0); PG8_SCHED; PG8_LDA(At, 1, 0); PG8_STAGE(PG8_SA(0, 1), a2 + hstep, voffA);
            PG8_WAIT_L(8); PG8_BAR; PG8_WAIT_L(0); PG8_MMA(0, 0, At, B0); PG8_BAR; PG8_SCHED;
            PG8_LDB(B1, 1, 1); PG8_STAGE(PG8_SB(1, 0), b3, vB);
            PG8_BAR; PG8_WAIT_L(0); PG8_MMA(0, 1, At, B1); PG8_BAR;
            PG8_LDA(At, 1, 1); PG8_STAGE(PG8_SA(1, 0), a3, voffA);
            PG8_BAR; PG8_WAIT_L(0); PG8_MMA(1, 0, At, B0); PG8_BAR; PG8_SCHED;
            PG8_STAGE(PG8_SB(1, 1), b3 + hB, vB);
            PG8_WAIT_V(6); PG8_BAR; PG8_MMA(1, 1, At, B1); PG8_BAR;
            }
        }
        if constexpr (ALIGN_EPI) { if (wr == 0) PG8_BAR; }
        if constexpr (!Epi::AFTER_DRAIN) { E(acc, cur, wr, wc, fr, fq); S.done(cur); }
        if (!has_next) break;
#pragma unroll
        for (int a = 0; a < 2; ++a)
#pragma unroll
            for (int b = 0; b < 2; ++b)
#pragma unroll
                for (int m = 0; m < 4; ++m)
#pragma unroll
                    for (int n = 0; n < 2; ++n) acc[a][b][m][n] = (f32x4){0.f, 0.f, 0.f, 0.f};
        cur = nxt; cA = nA; cB = nB; bsc = bsn; hBc = hBn; ++ui;
        if constexpr (ALIGN_EPI) { if (wr == 1) PG8_BAR; }
    }
    PG8_WAIT_V(0);
    if constexpr (!ALIGN_EPI) { if (wr == 0) PG8_BAR; }
    PG8_BAR;
    if constexpr (Epi::AFTER_DRAIN) { E.fused(acc, cur, wr, wc, fr, fq, lds, wid, lane); S.done(cur); }
#undef PG8_SA
#undef PG8_SB
#undef PG8_STAGE
#undef PG8_LDA
#undef PG8_LDB
#undef PG8_MMA
#undef PG8_WAIT_V
#undef PG8_WAIT_L
#undef PG8_BAR
#undef PG8_SCHED
}
}

using pg8::f32x4;
using pg8::bf16_t;
typedef short s16x8 __attribute__((ext_vector_type(8)));
typedef short s16x4 __attribute__((ext_vector_type(4)));
typedef float f32x16 __attribute__((ext_vector_type(16)));
typedef unsigned u32x2 __attribute__((ext_vector_type(2)));
typedef unsigned u32x4v __attribute__((ext_vector_type(4)));
#define LAS __attribute__((address_space(3)))

constexpr int BATCH = 16, SEQ = 4096, DM = 1024, DEPTH = 4, DFF = 4096, INC = 7328;
constexpr int NCHUNK = 2, CB = BATCH / NCHUNK, TC = CB * SEQ;
constexpr float EPS = 1e-6f;
constexpr int NWIN = 7424;
constexpr int NPROJ = 6144, NSWV = 1280;

constexpr size_t al256(size_t x) { return (x + 255) & ~(size_t)255; }
constexpr size_t O_CTL = 0;
constexpr size_t O_BAR = 4096;
constexpr size_t O_TABA = 4096 + 16384;
constexpr size_t O_TABM = O_TABA + (size_t)SEQ * 8 * 8;
constexpr size_t O_WIN = O_TABM + (size_t)SEQ * 16 * 8;
constexpr size_t S_WIN = (size_t)NWIN * 1024 * 2;
constexpr size_t O_WQB = O_WIN + DEPTH * S_WIN;
constexpr size_t S_WQB = (size_t)768 * 256 * 2;
constexpr size_t O_WKVB = O_WQB + DEPTH * S_WQB;
constexpr size_t S_WKVB = (size_t)1024 * 128 * 2;
constexpr size_t O_WBRA = O_WKVB + DEPTH * S_WKVB;
constexpr size_t S_WBRA = (size_t)1024 * 256 * 2;
constexpr size_t O_WBRB = O_WBRA + DEPTH * S_WBRA;
constexpr size_t S_WBRB = (size_t)1024 * 512 * 2;
constexpr size_t S_WBR = (size_t)1024 * 1280 * 2;
constexpr size_t O_WBRC = O_WBRB + DEPTH * S_WBRB;
constexpr size_t O_WOUT = O_WBRC + DEPTH * S_WBRB;
constexpr size_t S_WOUT = (size_t)1024 * 1024 * 2;
constexpr size_t O_W1 = O_WOUT + DEPTH * S_WOUT;
constexpr size_t S_W1 = (size_t)4096 * 1024 * 2;
constexpr size_t O_W2 = O_W1 + DEPTH * S_W1;
constexpr size_t O_ACT = al256(O_W2 + DEPTH * S_W1);
constexpr size_t O_XN = O_ACT;
constexpr size_t O_AQ = O_XN + (size_t)TC * 1024 * 2;
constexpr size_t O_AK = O_AQ + (size_t)TC * 768 * 2;
constexpr size_t O_AVT = O_AK + (size_t)TC * 768 * 2;
constexpr size_t O_BQL = O_AVT + (size_t)TC * 768 * 2;
constexpr size_t O_BKV = O_BQL + (size_t)TC * 256 * 2;
constexpr size_t O_KVAN = O_BKV + (size_t)TC * 256 * 2;
constexpr size_t O_CQ = O_KVAN + (size_t)TC * 128 * 2;
constexpr size_t O_CK = O_CQ + (size_t)TC * 512 * 2;
constexpr size_t O_CVT = O_CK + (size_t)TC * 512 * 2;
constexpr size_t O_GATE = O_CVT + (size_t)TC * 512 * 2;
constexpr size_t O_BQ = O_GATE + (size_t)TC * 3072 * 2;
constexpr size_t O_BKN = O_BQ + (size_t)TC * 768 * 2;
constexpr size_t O_BK = O_BKN + (size_t)TC * 512 * 2;
constexpr size_t O_BVT = O_BK + (size_t)TC * 768 * 2;
constexpr size_t O_OA = O_BVT + (size_t)TC * 512 * 2;
constexpr size_t O_OB = O_OA + (size_t)TC * 256 * 2;
constexpr size_t O_OC = O_OB + (size_t)TC * 512 * 2;
constexpr size_t O_OG = O_OC + (size_t)TC * 512 * 2;
constexpr size_t O_LSE = O_OG + (size_t)TC * 768 * 2;
constexpr size_t O_KR = O_LSE + (size_t)TC * 12 * 4;
constexpr size_t O_SSQ = O_KR + (size_t)TC * 32 * 2;
constexpr size_t WS_END = O_SSQ + (size_t)TC * 2 * 4 * 4;
constexpr size_t O_MF = O_AQ;
constexpr size_t O_U = O_AQ;
static_assert((size_t)TC * 1024 * 4 <= O_BQL - O_AQ, "MF overlay");
static_assert(O_U + (size_t)TC * 4096 * 2 <= WS_END, "U overlay");

constexpr int LDS_BYTES = 131072 + 1024;

struct Args {
    const float* in[16];
    float* out; unsigned char* ws;
    float invfA[8]; float invfM[16];
};

__device__ __forceinline__ unsigned cvtpk(float lo, float hi) { unsigned r; asm volatile("v_cvt_pk_bf16_f32 %0, %1, %2" : "=v"(r) : "v"(lo), "v"(hi)); return r; }
__device__ __forceinline__ u32x4v pack8(const f32x4 a, const f32x4 b) { u32x4v w; w.x = cvtpk(a[0], a[1]); w.y = cvtpk(a[2], a[3]); w.z = cvtpk(b[0], b[1]); w.w = cvtpk(b[2], b[3]); return w; }
__device__ __forceinline__ float bf2f(unsigned short h) { return __builtin_bit_cast(float, (unsigned)h << 16); }
__device__ __forceinline__ unsigned short f2bf1(float f) { return (unsigned short)(cvtpk(f, 0.f) & 0xffffu); }
template <int CTRL> __device__ __forceinline__ float dpp_f(float x) { return __builtin_bit_cast(float, __builtin_amdgcn_update_dpp(0, __builtin_bit_cast(int, x), CTRL, 0xf, 0xf, true)); }
__device__ __forceinline__ float row_sum16(float x) {
    x += dpp_f<0xB1>(x);
    x += dpp_f<0x4E>(x);
    x += dpp_f<0x141>(x);
    x += dpp_f<0x140>(x);
    return x;
}
__device__ __forceinline__ float lane_x32(float x, int hi) {
    const unsigned b = __builtin_bit_cast(unsigned, x);
    const auto r = __builtin_amdgcn_permlane32_swap(b, b, false, false);
    return __builtin_bit_cast(float, hi ? (unsigned)r[0] : (unsigned)r[1]);
}
__device__ __forceinline__ float wave_sum(float v) { v = row_sum16(v); v += __shfl_xor(v, 16); v += lane_x32(v, (int)(__lane_id() >> 5)); return v; }
__device__ __forceinline__ float fexp2(float x) { return __builtin_amdgcn_exp2f(x); }
__device__ __forceinline__ float flog2(float x) { return __builtin_amdgcn_logf(x); }
constexpr float LOG2E = 1.4426950408889634f, LN2 = 0.6931471805599453f;

struct EpiProj {
    static constexpr bool PERM = false, AFTER_DRAIN = false;
    unsigned char* ws; const float* gaq; const float* gak;
    __device__ __forceinline__ void operator()(const f32x4 (&acc)[2][2][4][2], const pg8::Unit& u, int wr, int wc, int fr, int fq) const {
        const int pn = u.pn;
        const int row0 = u.pm * 256 + wr * 64 + fr;
        if (pn < 6) {
            const bool isk = pn >= 3; const int head = 4 * (isk ? pn - 3 : pn) + wc;
            bf16_t* base = (bf16_t*)(ws + (isk ? O_AK : O_AQ)) + head * 64 + 8 * fq;
            const float* gp = (isk ? gak : gaq) + 8 * fq;
            f32x4 gv[2][2];
#pragma unroll
            for (int bj = 0; bj < 2; ++bj)
#pragma unroll
                for (int n = 0; n < 2; ++n) gv[bj][n] = *(const f32x4*)(gp + 32 * bj + 4 * n);
            const float* tab = (const float*)(ws + O_TABA);
            f32x4 nt[4];
            { const float* tp0 = tab + (size_t)(row0 & (SEQ - 1)) * 16;
#pragma unroll
              for (int q = 0; q < 4; ++q) nt[q] = *(const f32x4*)(tp0 + 4 * q); }
#pragma unroll
            for (int ai = 0; ai < 2; ++ai)
#pragma unroll
                for (int m = 0; m < 4; ++m) {
                    const int row = row0 + ai * 128 + m * 16;
                    const f32x4 t0 = nt[0], t1 = nt[1], t2 = nt[2], t3 = nt[3];
                    if (ai * 4 + m + 1 < 8) {
                        const int rown = row0 + ((ai * 4 + m + 1) >> 2) * 128 + ((ai * 4 + m + 1) & 3) * 16; const float* tpn = tab + (size_t)(rown & (SEQ - 1)) * 16;
#pragma unroll
                        for (int q = 0; q < 4; ++q) nt[q] = *(const f32x4*)(tpn + 4 * q); }
                    float ss = 0.f;
#pragma unroll
                    for (int bj = 0; bj < 2; ++bj)
#pragma unroll
                        for (int n = 0; n < 2; ++n) { const f32x4 v = acc[ai][bj][m][n]; ss += (v[0] * v[0] + v[1] * v[1]) + (v[2] * v[2] + v[3] * v[3]); }
                    ss += __shfl_xor(ss, 16); ss += lane_x32(ss, fq >> 1);
                    const float rs = __builtin_amdgcn_rsqf(ss * (1.f / 64.f) + EPS);
                    f32x4 y[2][2];
#pragma unroll
                    for (int bj = 0; bj < 2; ++bj)
#pragma unroll
                        for (int n = 0; n < 2; ++n) y[bj][n] = acc[ai][bj][m][n] * rs * gv[bj][n];
                    const float cs[8] = {t0[0], t0[2], t1[0], t1[2], t2[0], t2[2], t3[0], t3[2]}, sn[8] = {t0[1], t0[3], t1[1], t1[3], t2[1], t2[3], t3[1], t3[3]};
                    f32x4 yr[2];
#pragma unroll
                    for (int n = 0; n < 2; ++n)
#pragma unroll
                        for (int e = 0; e < 4; ++e) { const float pr = __shfl_xor(y[0][n][e], 16); const float v = y[0][n][e], c_ = cs[4 * n + e], s_ = sn[4 * n + e];
                            yr[n][e] = (fq == 0) ? (v * c_ - pr * s_) : ((fq == 1) ? (v * c_ + pr * s_) : v); }
                    y[0][0] = yr[0]; y[0][1] = yr[1];
                    bf16_t* rowp = base + (size_t)row * 768;
#pragma unroll
                    for (int bj = 0; bj < 2; ++bj) *(u32x4v*)(rowp + 32 * bj) = pack8(y[bj][0], y[bj][1]);
                }
            return;
        }
        if (pn == 6 || pn == 7) {
            float* ssq = (float*)(ws + O_SSQ) + (pn == 7 ? (size_t)TC * 4 : 0);
#pragma unroll
            for (int ai = 0; ai < 2; ++ai)
#pragma unroll
                for (int m = 0; m < 4; ++m) {
                    const int row = row0 + ai * 128 + m * 16;
                    float ss = 0.f;
#pragma unroll
                    for (int bj = 0; bj < 2; ++bj) {
                        const f32x4 v0 = acc[ai][bj][m][0], v1 = acc[ai][bj][m][1];
                        const u32x4v w = pack8(v0, v1);
                        const float sq = ((v0[0] * v0[0] + v0[1] * v0[1]) + (v0[2] * v0[2] + v0[3] * v0[3])) + ((v1[0] * v1[0] + v1[1] * v1[1]) + (v1[2] * v1[2] + v1[3] * v1[3]));
                        const int cl = wc * 32 + 8 * fq;
                        if (pn == 6) { *(u32x4v*)((bf16_t*)(ws + O_BQL) + (size_t)row * 256 + bj * 128 + cl) = w; ss += sq; }
                        else if (bj == 0) { *(u32x4v*)((bf16_t*)(ws + O_KVAN) + (size_t)row * 128 + cl) = w; ss += sq; }
                        else if (wc == 0) { *(u32x4v*)((bf16_t*)(ws + O_KR) + (size_t)row * 32 + cl) = w; }
                    }
                    ss += __shfl_xor(ss, 16); ss += lane_x32(ss, fq >> 1);
                    if (fq == 0) ssq[(size_t)row * 4 + wc] = ss;
                }
            return;
        }
        if (pn >= 12) {
            unsigned char* gb = (unsigned char*)(ws + O_GATE) + (size_t)row0 * 3072 + (pn - 12) * 256 + wc * 32 + 8 * fq;
#pragma unroll
            for (int ai = 0; ai < 2; ++ai)
#pragma unroll
                for (int m = 0; m < 4; ++m) {
                    unsigned char* rowp = gb + (size_t)(ai * 128 + m * 16) * 3072;
#pragma unroll
                    for (int bj = 0; bj < 2; ++bj) {
                        u32x2 w;
#pragma unroll
                        for (int n = 0; n < 2; ++n) { const f32x4 v = acc[ai][bj][m][n]; unsigned q[4];
#pragma unroll
                            for (int e = 0; e < 4; ++e) q[e] = (unsigned)(__builtin_amdgcn_rcpf(1.f + fexp2(-v[e] * LOG2E)) * 255.f + 0.5f);
                            const unsigned pk = q[0] | (q[1] << 8) | (q[2] << 16) | (q[3] << 24); if (n == 0) w.x = pk; else w.y = pk; }
                        *(u32x2*)(rowp + bj * 128) = w;
                    }
                }
            return;
        }
        bf16_t* base; int c0;
        if (pn < 10) { base = (bf16_t*)(ws + O_CQ); c0 = (pn - 8) * 256; }
        else { base = (bf16_t*)(ws + O_CK); c0 = (pn - 10) * 256; }
        const int col0 = c0 + wc * 32 + 8 * fq;
#pragma unroll
        for (int ai = 0; ai < 2; ++ai)
#pragma unroll
            for (int m = 0; m < 4; ++m) {
                bf16_t* rowp = base + (size_t)(row0 + ai * 128 + m * 16) * 512 + col0;
#pragma unroll
                for (int bj = 0; bj < 2; ++bj) *(u32x4v*)(rowp + bj * 128) = pack8(acc[ai][bj][m][0], acc[ai][bj][m][1]);
            }
    }
};
struct EpiSwapV {
    static constexpr bool PERM = false, AFTER_DRAIN = false;
    bf16_t *AVt, *CVt;
    __device__ __forceinline__ void operator()(const f32x4 (&acc)[2][2][4][2], const pg8::Unit& u, int wr, int wc, int fr, int fq) const {
        const int pm = u.pm;
        const int row0 = (pm < 3 ? pm * 256 : (pm - 3) * 256) + wr * 64 + fr, col0 = u.pn * 256 + wc * 32 + 4 * fq;
        bf16_t* base = pm < 3 ? AVt : CVt;
#pragma unroll
        for (int ai = 0; ai < 2; ++ai)
#pragma unroll
            for (int m = 0; m < 4; ++m) {
                bf16_t* rowp = base + (size_t)(row0 + ai * 128 + m * 16) * TC + col0;
#pragma unroll
                for (int bj = 0; bj < 2; ++bj)
#pragma unroll
                    for (int n = 0; n < 2; ++n) {
                        const f32x4 v = acc[ai][bj][m][n];
                        u32x2 w; w.x = cvtpk(v[0], v[1]); w.y = cvtpk(v[2], v[3]);
                        *(u32x2*)(rowp + bj * 128 + n * 16) = w;
                    }
            }
    }
};
template <int ACT  , int SCL  > struct EpiBf {
    static constexpr bool PERM = false, AFTER_DRAIN = false;
    bf16_t* O; int ldc; const float* ssq; float invn;
    __device__ __forceinline__ void operator()(const f32x4 (&acc)[2][2][4][2], const pg8::Unit& u, int wr, int wc, int fr, int fq) const {
        const int row0 = u.pm * 256 + wr * 64 + fr, col0 = u.pn * 256 + wc * 32 + 4 * fq;
        f32x4 cscl[2][2];
        if (SCL == 2) {
#pragma unroll
            for (int bj = 0; bj < 2; ++bj)
#pragma unroll
                for (int n = 0; n < 2; ++n) {
#pragma unroll
                    for (int e = 0; e < 4; ++e) { const f32x4 q = *(const f32x4*)(ssq + (size_t)(col0 + bj * 128 + n * 16 + e) * 4); cscl[bj][n][e] = __builtin_amdgcn_rsqf(((q[0] + q[1]) + (q[2] + q[3])) * invn + EPS); } }
        }
        float rsc[8];
        if (SCL == 1) {
#pragma unroll
            for (int g = 0; g < 8; ++g) { const f32x4 q = *(const f32x4*)(ssq + (size_t)(row0 + (g >> 2) * 128 + (g & 3) * 16) * 4); rsc[g] = __builtin_amdgcn_rsqf(((q[0] + q[1]) + (q[2] + q[3])) * invn + EPS); }
        }
#pragma unroll
        for (int ai = 0; ai < 2; ++ai)
#pragma unroll
            for (int m = 0; m < 4; ++m) {
                const int row = row0 + ai * 128 + m * 16;
                bf16_t* rowp = O + (size_t)row * ldc + col0;
                float rscl = 1.f;
                if (SCL == 1) rscl = rsc[ai * 4 + m];
#pragma unroll
                for (int bj = 0; bj < 2; ++bj)
#pragma unroll
                    for (int n = 0; n < 2; ++n) {
                        f32x4 v = acc[ai][bj][m][n];
                        if (SCL == 1) v = v * rscl;
                        if (SCL == 2) v = v * cscl[bj][n];
                        if (ACT == 1) {
#pragma unroll
                            for (int e = 0; e < 4; ++e) { const float r = fmaxf(v[e], 0.f); v[e] = r * r; }
                        }
                        u32x2 w; w.x = cvtpk(v[0], v[1]); w.y = cvtpk(v[2], v[3]);
                        *(u32x2*)(rowp + bj * 128 + n * 16) = w;
                    }
            }
    }
};
struct EpiGcat {
    const unsigned char* GATE; bf16_t* MG;
    static __device__ __forceinline__ f32x4 g4u(const unsigned w) { f32x4 r;
        r[0] = fmaxf((float)(w & 0xffu) * (1.f / 255.f), 1e-18f); r[1] = fmaxf((float)((w >> 8) & 0xffu) * (1.f / 255.f), 1e-18f);
        r[2] = fmaxf((float)((w >> 16) & 0xffu) * (1.f / 255.f), 1e-18f); r[3] = fmaxf((float)(w >> 24) * (1.f / 255.f), 1e-18f); return r; }
    __device__ __forceinline__ void mid(f32x4 (&acc)[2][2][4][2], const pg8::Unit& u, int wr, int wc, int fr, int fq, int seg) const {
        asm volatile("" : "+v"(fr), "+v"(fq));
        const int row0 = u.pm * 256 + wr * 64 + fr, col0 = u.pn * 256 + wc * 32 + 4 * fq;
        const unsigned char* gbase = GATE + (size_t)row0 * 3072 + seg * 1024 + col0;
        unsigned cn[4], cd[4], nn[4], nd[4];
#pragma unroll
        for (int q = 0; q < 4; ++q) { cn[q] = *(const unsigned*)(gbase + (q >> 1) * 128 + (q & 1) * 16); cd[q] = *(const unsigned*)(gbase + 1024 + (q >> 1) * 128 + (q & 1) * 16); }
#pragma unroll
        for (int g = 0; g < 8; ++g) {
            const int ai = g >> 2, m = g & 3;
            if (g + 1 < 8) { const unsigned char* gp = gbase + (size_t)(((g + 1) >> 2) * 128 + ((g + 1) & 3) * 16) * 3072;
#pragma unroll
                for (int q = 0; q < 4; ++q) { nn[q] = *(const unsigned*)(gp + (q >> 1) * 128 + (q & 1) * 16); nd[q] = *(const unsigned*)(gp + 1024 + (q >> 1) * 128 + (q & 1) * 16); } }
#pragma unroll
            for (int q = 0; q < 4; ++q) { const f32x4 num = g4u(cn[q]), den = g4u(cd[q]);
#pragma unroll
                for (int e = 0; e < 4; ++e) acc[ai][q >> 1][m][q & 1][e] *= num[e] * __builtin_amdgcn_rcpf(den[e]); }
            asm volatile("" ::: "memory");
#pragma unroll
            for (int q = 0; q < 4; ++q) { cn[q] = nn[q]; cd[q] = nd[q]; }
        }
    }
    __device__ __forceinline__ void operator()(const f32x4 (&acc)[2][2][4][2], const pg8::Unit& u, int wr, int wc, int fr, int fq) const {
        const int row0 = u.pm * 256 + wr * 64 + fr, col0 = u.pn * 256 + wc * 32 + 4 * fq;
        const unsigned char* gbase = GATE + (size_t)row0 * 3072 + 2048 + col0;
        unsigned cg[4], ng[4];
#pragma unroll
        for (int q = 0; q < 4; ++q) cg[q] = *(const unsigned*)(gbase + (q >> 1) * 128 + (q & 1) * 16);
#pragma unroll
        for (int g = 0; g < 8; ++g) {
            const int ai = g >> 2, m = g & 3;
            if (g + 1 < 8) { const unsigned char* gp = gbase + (size_t)(((g + 1) >> 2) * 128 + ((g + 1) & 3) * 16) * 3072;
#pragma unroll
                for (int q = 0; q < 4; ++q) ng[q] = *(const unsigned*)(gp + (q >> 1) * 128 + (q & 1) * 16); }
            bf16_t* op = MG + (size_t)(row0 + ai * 128 + m * 16) * 1024 + col0;
#pragma unroll
            for (int q = 0; q < 4; ++q) { const f32x4 v = acc[ai][q >> 1][m][q & 1] * g4u(cg[q]);
                u32x2 w; w.x = cvtpk(v[0], v[1]); w.y = cvtpk(v[2], v[3]); *(u32x2*)(op + (q >> 1) * 128 + (q & 1) * 16) = w; }
            asm volatile("" ::: "memory");
#pragma unroll
            for (int q = 0; q < 4; ++q) cg[q] = ng[q];
        }
    }
};
struct EpiResid {
    static constexpr bool PERM = false, AFTER_DRAIN = false;
    const float* base; float* out;
    __device__ __forceinline__ void operator()(const f32x4 (&acc)[2][2][4][2], const pg8::Unit& u, int wr, int wc, int fr, int fq) const {
        const int row0 = u.pm * 256 + wr * 64 + fr, col0 = u.pn * 256 + wc * 32 + 4 * fq;
        const size_t off0 = (size_t)row0 * 1024 + col0;
        f32x4 cb[4], nb[4];
#pragma unroll
        for (int q = 0; q < 4; ++q) cb[q] = *(const f32x4*)(base + off0 + (q >> 1) * 128 + (q & 1) * 16);
#pragma unroll
        for (int g = 0; g < 8; ++g) {
            const int ai = g >> 2, m = g & 3;
            if (g + 1 < 8) { const size_t offn = off0 + (size_t)(((g + 1) >> 2) * 128 + ((g + 1) & 3) * 16) * 1024;
#pragma unroll
                for (int q = 0; q < 4; ++q) nb[q] = *(const f32x4*)(base + offn + (q >> 1) * 128 + (q & 1) * 16); }
            const size_t off = off0 + (size_t)(ai * 128 + m * 16) * 1024;
#pragma unroll
            for (int q = 0; q < 4; ++q) *(f32x4*)(out + off + (q >> 1) * 128 + (q & 1) * 16) = cb[q] + acc[ai][q >> 1][m][q & 1];
            asm volatile("" ::: "memory");
#pragma unroll
            for (int q = 0; q < 4; ++q) cb[q] = nb[q];
        }
    }
};

struct EpiSwapVP {
    bf16_t *AVt, *CVt;
    __device__ __forceinline__ void operator()(const f32x4 (&acc)[2][2][4][2], const pg8::Unit& u, int wr, int wc, int fr, int fq) const {
        const int pm = u.pm;
        const int row0 = (pm < 3 ? pm * 256 : (pm - 3) * 256) + wr * 64 + fr, col0 = u.pn * 256 + wc * 32 + 8 * fq;
        bf16_t* base = (pm < 3 ? AVt : CVt) + (size_t)row0 * TC + col0;
#pragma unroll
        for (int ai = 0; ai < 2; ++ai)
#pragma unroll
            for (int m = 0; m < 4; ++m)
#pragma unroll
                for (int bj = 0; bj < 2; ++bj) *(u32x4v*)(base + (size_t)(ai * 128 + m * 16) * TC + bj * 128) = pack8(acc[ai][bj][m][0], acc[ai][bj][m][1]);
    }
};
template <int SCL  > struct EpiBfP {
    bf16_t* O; int ldc; const float* ssq; float invn;
    __device__ __forceinline__ void operator()(const f32x4 (&acc)[2][2][4][2], const pg8::Unit& u, int wr, int wc, int fr, int fq) const {
        const int row0 = u.pm * 256 + wr * 64 + fr, col0 = u.pn * 256 + wc * 32 + 8 * fq;
        float rsc[8]; f32x4 csc[2][2];
        if (SCL == 1) {
#pragma unroll
            for (int g = 0; g < 8; ++g) { const f32x4 q = *(const f32x4*)(ssq + (size_t)(row0 + (g >> 2) * 128 + (g & 3) * 16) * 4); rsc[g] = __builtin_amdgcn_rsqf(((q[0] + q[1]) + (q[2] + q[3])) * invn + EPS); }
        } else {
#pragma unroll
            for (int bj = 0; bj < 2; ++bj)
#pragma unroll
                for (int e = 0; e < 8; ++e) { const f32x4 q = *(const f32x4*)(ssq + (size_t)(col0 + bj * 128 + e) * 4); csc[bj][e >> 2][e & 3] = __builtin_amdgcn_rsqf(((q[0] + q[1]) + (q[2] + q[3])) * invn + EPS); }
        }
#pragma unroll
        for (int ai = 0; ai < 2; ++ai)
#pragma unroll
            for (int m = 0; m < 4; ++m)
#pragma unroll
                for (int bj = 0; bj < 2; ++bj) {
                    f32x4 v0 = acc[ai][bj][m][0], v1 = acc[ai][bj][m][1];
                    if (SCL == 1) { v0 = v0 * rsc[ai * 4 + m]; v1 = v1 * rsc[ai * 4 + m]; } else { v0 = v0 * csc[bj][0]; v1 = v1 * csc[bj][1]; }
                    *(u32x4v*)(O + (size_t)(row0 + ai * 128 + m * 16) * ldc + col0 + bj * 128) = pack8(v0, v1);
                }
    }
};
struct EpiGcatP {
    const unsigned char* GATE; bf16_t* MG;
    static __device__ __forceinline__ void g8(const u32x2 w, f32x4& a, f32x4& b) { a = EpiGcat::g4u(w.x); b = EpiGcat::g4u(w.y); }
    __device__ __forceinline__ void mid(f32x4 (&acc)[2][2][4][2], const pg8::Unit& u, int wr, int wc, int fr, int fq, int seg) const {
        asm volatile("" : "+v"(fr), "+v"(fq));
        const int row0 = u.pm * 256 + wr * 64 + fr, col0 = u.pn * 256 + wc * 32 + 8 * fq;
        const unsigned char* gbase = GATE + (size_t)row0 * 3072 + seg * 1024 + col0;
        u32x2 cn[2], cd[2], nn[2], nd[2];
#pragma unroll
        for (int bj = 0; bj < 2; ++bj) { cn[bj] = *(const u32x2*)(gbase + bj * 128); cd[bj] = *(const u32x2*)(gbase + 1024 + bj * 128); }
#pragma unroll
        for (int g = 0; g < 8; ++g) {
            const int ai = g >> 2, m = g & 3;
            if (g + 1 < 8) { const unsigned char* gp = gbase + (size_t)(((g + 1) >> 2) * 128 + ((g + 1) & 3) * 16) * 3072;
#pragma unroll
                for (int bj = 0; bj < 2; ++bj) { nn[bj] = *(const u32x2*)(gp + bj * 128); nd[bj] = *(const u32x2*)(gp + 1024 + bj * 128); } }
#pragma unroll
            for (int bj = 0; bj < 2; ++bj) { f32x4 n0, n1, d0, d1; g8(cn[bj], n0, n1); g8(cd[bj], d0, d1);
#pragma unroll
                for (int e = 0; e < 4; ++e) { acc[ai][bj][m][0][e] *= n0[e] * __builtin_amdgcn_rcpf(d0[e]); acc[ai][bj][m][1][e] *= n1[e] * __builtin_amdgcn_rcpf(d1[e]); } }
            asm volatile("" ::: "memory");
#pragma unroll
            for (int bj = 0; bj < 2; ++bj) { cn[bj] = nn[bj]; cd[bj] = nd[bj]; }
        }
    }
    __device__ __forceinline__ void operator()(const f32x4 (&acc)[2][2][4][2], const pg8::Unit& u, int wr, int wc, int fr, int fq) const {
        const int row0 = u.pm * 256 + wr * 64 + fr, col0 = u.pn * 256 + wc * 32 + 8 * fq;
        const unsigned char* gbase = GATE + (size_t)row0 * 3072 + 2048 + col0;
        u32x2 cg[2], ng[2];
#pragma unroll
        for (int bj = 0; bj < 2; ++bj) cg[bj] = *(const u32x2*)(gbase + bj * 128);
#pragma unroll
        for (int g = 0; g < 8; ++g) {
            const int ai = g >> 2, m = g & 3;
            if (g + 1 < 8) { const unsigned char* gp = gbase + (size_t)(((g + 1) >> 2) * 128 + ((g + 1) & 3) * 16) * 3072;
#pragma unroll
                for (int bj = 0; bj < 2; ++bj) ng[bj] = *(const u32x2*)(gp + bj * 128); }
            bf16_t* op = MG + (size_t)(row0 + ai * 128 + m * 16) * 1024 + col0;
#pragma unroll
            for (int bj = 0; bj < 2; ++bj) { f32x4 g0, g1; g8(cg[bj], g0, g1); *(u32x4v*)(op + bj * 128) = pack8(acc[ai][bj][m][0] * g0, acc[ai][bj][m][1] * g1); }
            asm volatile("" ::: "memory");
#pragma unroll
            for (int bj = 0; bj < 2; ++bj) cg[bj] = ng[bj];
        }
    }
};
enum { M_PROJ = 0, M_SWAPV, M_BQ, M_BKN, M_BVT, M_U, M_GCAT, M_RES };
struct EpiDyn {
    static constexpr bool PERM = false, AFTER_DRAIN = false;
    unsigned char* ws; int mode; const float* rbase; float* rout; const float* g0; const float* g1;
    static constexpr bool HAS_MID = true;
    __device__ __forceinline__ bool perm_b() const { return mode != M_RES; }
    __device__ __forceinline__ bool mid_at(int t) const { return mode == M_GCAT && (t == 4 || t == 12); }
    __device__ __forceinline__ void mid(f32x4 (&acc)[2][2][4][2], const pg8::Unit& u, int wr, int wc, int fr, int fq, int t) const {
        EpiGcatP E{(const unsigned char*)(ws + O_GATE), (bf16_t*)(ws + O_XN)}; E.mid(acc, u, wr, wc, fr, fq, t == 4 ? 0 : 1); }
    __device__ __forceinline__ void operator()(const f32x4 (&acc)[2][2][4][2], const pg8::Unit& u, int wr, int wc, int fr, int fq) const {
        asm volatile("" : "+v"(fr), "+v"(fq));
        switch (mode) {
        case M_PROJ: { EpiProj E{ws, g0, g1}; E(acc, u, wr, wc, fr, fq); } break;
        case M_SWAPV: { EpiSwapVP E{(bf16_t*)(ws + O_AVT), (bf16_t*)(ws + O_CVT)}; E(acc, u, wr, wc, fr, fq); } break;
        case M_BQ: { EpiBfP<1> E{(bf16_t*)(ws + O_BQ), 768, (const float*)(ws + O_SSQ), 1.f / 256.f}; E(acc, u, wr, wc, fr, fq); } break;
        case M_BKN: { EpiBfP<1> E{(bf16_t*)(ws + O_BKN), 512, (const float*)(ws + O_SSQ) + (size_t)TC * 4, 1.f / 128.f}; E(acc, u, wr, wc, fr, fq); } break;
        case M_BVT: { EpiBfP<2> E{(bf16_t*)(ws + O_BVT), TC, (const float*)(ws + O_SSQ) + (size_t)TC * 4, 1.f / 128.f}; E(acc, u, wr, wc, fr, fq); } break;
        case M_U: {
            bf16_t* ob = (bf16_t*)(ws + O_U) + (size_t)(u.pm * 256 + wr * 64 + fr) * 4096 + u.pn * 256 + wc * 32 + 8 * fq;
#pragma unroll
            for (int ai = 0; ai < 2; ++ai)
#pragma unroll
                for (int m = 0; m < 4; ++m)
#pragma unroll
                    for (int bj = 0; bj < 2; ++bj) {
                        f32x4 v0 = acc[ai][bj][m][0], v1 = acc[ai][bj][m][1];
#pragma unroll
                        for (int e = 0; e < 4; ++e) { const float a = fmaxf(v0[e], 0.f), b = fmaxf(v1[e], 0.f); v0[e] = a * a; v1[e] = b * b; }
                        u32x4v w; w.x = cvtpk(v0[0], v0[1]); w.y = cvtpk(v0[2], v0[3]); w.z = cvtpk(v1[0], v1[1]); w.w = cvtpk(v1[2], v1[3]);
                        *(u32x4v*)(ob + (size_t)(ai * 128 + m * 16) * 4096 + bj * 128) = w;
                    }
        } break;
        case M_GCAT: { EpiGcatP E{(const unsigned char*)(ws + O_GATE), (bf16_t*)(ws + O_XN)}; E(acc, u, wr, wc, fr, fq); } break;
        default: { EpiResid E{rbase, rout}; E(acc, u, wr, wc, fr, fq); } break;
        }
    }
};

__device__ __forceinline__ void tr_seg(const float* W, int ldn, int K, int col0, int ncols, bf16_t* WT, int dstrow0, LAS float* scr, int gw, int NGW, int lane, unsigned& ibase, const float* kg = nullptr, int ldk = 0, int kofs = 0) {
    if (ldk == 0) ldk = K;
    const int nblk = ncols / 32, items = (K / 64) * nblk;
    int it = (int)(((unsigned)gw + (unsigned)NGW - ibase % (unsigned)NGW) % (unsigned)NGW);
    for (; it < items; it += NGW) {
        const int kb = it / nblk, nb = it % nblk, k0 = 64 * kb, n0 = 32 * nb;
#pragma unroll
        for (int i = 0; i < 32; ++i) { const int kk = 2 * i + (lane >> 5); scr[kk * 33 + (lane & 31)] = W[(size_t)(k0 + kk) * ldn + col0 + n0 + (lane & 31)] * (kg ? kg[k0 + kk] : 1.f); }
        asm volatile("s_waitcnt lgkmcnt(0)" ::: "memory");
        const int c = lane & 7;
#pragma unroll
        for (int j = 0; j < 4; ++j) { const int n = (lane >> 3) + 8 * j; const LAS float* s = scr + (8 * c) * 33 + n;
            u32x4v o; o.x = cvtpk(s[0 * 33], s[1 * 33]); o.y = cvtpk(s[2 * 33], s[3 * 33]); o.z = cvtpk(s[4 * 33], s[5 * 33]); o.w = cvtpk(s[6 * 33], s[7 * 33]);
            *(u32x4v*)(WT + (size_t)(dstrow0 + n0 + n) * ldk + kofs + k0 + 8 * c) = o; }
        asm volatile("s_waitcnt lgkmcnt(0)" ::: "memory");
    }
    ibase += (unsigned)items;
}

__device__ __forceinline__ void rms_rows(const float* x, const float* gain, bf16_t* out, int nrows, int gw, int NGW, int lane) {
    f32x4 gv[4];
#pragma unroll
    for (int j = 0; j < 4; ++j) gv[j] = *((const f32x4*)gain + 64 * j + lane);
    f32x4 v[4], nv[4];
    if (gw < nrows) {
#pragma unroll
        for (int j = 0; j < 4; ++j) v[j] = ((const f32x4*)(x + (size_t)gw * 1024) + lane)[64 * j];
    }
    for (int r = gw; r < nrows; r += NGW) {
        if (r + NGW < nrows) {
#pragma unroll
            for (int j = 0; j < 4; ++j) nv[j] = ((const f32x4*)(x + (size_t)(r + NGW) * 1024) + lane)[64 * j];
        }
        float s = 0.f;
#pragma unroll
        for (int j = 0; j < 4; ++j) s += (v[j][0] * v[j][0] + v[j][1] * v[j][1]) + (v[j][2] * v[j][2] + v[j][3] * v[j][3]);
        const float rs = __builtin_amdgcn_rsqf(wave_sum(s) * (1.f / 1024.f) + EPS);
        u32x2* o = (u32x2*)(out + (size_t)r * 1024) + lane;
#pragma unroll
        for (int j = 0; j < 4; ++j) { u32x2 w; w.x = cvtpk(v[j][0] * rs * gv[j][0], v[j][1] * rs * gv[j][1]); w.y = cvtpk(v[j][2] * rs * gv[j][2], v[j][3] * rs * gv[j][3]); o[64 * j] = w; }
#pragma unroll
        for (int j = 0; j < 4; ++j) v[j] = nv[j];
    }
}
typedef float f32x2 __attribute__((ext_vector_type(2)));
__device__ __forceinline__ void post_proj(bf16_t* AQ, bf16_t* AK, bf16_t* BQL, const bf16_t* BKV, bf16_t* KVAN, const float* gaq, const float* gak, const float* gqa, const float* gkva,
                                          const f32x2* tabA, int gw, int NGW, int lane) {
    const float g_q = gaq[lane], g_k = gak[lane];
    f32x4 g4 = *((const f32x4*)gqa + lane); f32x2 g2 = *((const f32x2*)gkva + lane);
    for (int t = gw; t < TC; t += NGW) {
        const int s = t & (SEQ - 1);
        const f32x2 cs = tabA[s * 8 + (lane & 7)];
#pragma unroll 4
        for (int hh = 0; hh < 24; ++hh) {
            bf16_t* p = (hh < 12 ? AQ + (size_t)t * 768 + hh * 64 : AK + (size_t)t * 768 + (hh - 12) * 64) + lane;
            const float xv = bf2f(*p);
            const float rs = __builtin_amdgcn_rsqf(wave_sum(xv * xv) * (1.f / 64.f) + EPS);
            float y = xv * rs * (hh < 12 ? g_q : g_k);
            const float pr = __shfl_xor(y, 8);
            if (lane < 8) y = y * cs[0] - pr * cs[1]; else if (lane < 16) y = y * cs[0] + pr * cs[1];
            *p = f2bf1(y);
        }
        { u32x2* p = (u32x2*)(BQL + (size_t)t * 256) + lane; const u32x2 w = *p;
          const float a = __builtin_bit_cast(float, w.x << 16), b = __builtin_bit_cast(float, w.x & 0xffff0000u), c = __builtin_bit_cast(float, w.y << 16), d = __builtin_bit_cast(float, w.y & 0xffff0000u);
          const float rs = __builtin_amdgcn_rsqf(wave_sum((a * a + b * b) + (c * c + d * d)) * (1.f / 256.f) + EPS);
          u32x2 o; o.x = cvtpk(a * rs * g4[0], b * rs * g4[1]); o.y = cvtpk(c * rs * g4[2], d * rs * g4[3]); *p = o; }
        { const unsigned w = *((const unsigned*)(BKV + (size_t)t * 256) + lane);
          const float a = __builtin_bit_cast(float, w << 16), b = __builtin_bit_cast(float, w & 0xffff0000u);
          const float rs = __builtin_amdgcn_rsqf(wave_sum(a * a + b * b) * (1.f / 128.f) + EPS);
          *((unsigned*)(KVAN + (size_t)t * 128) + lane) = cvtpk(a * rs * g2[0], b * rs * g2[1]); }
    }
}
__device__ __forceinline__ float half_sum(float v) { v = row_sum16(v); v += __shfl_xor(v, 16); return v; }
__device__ __forceinline__ void post_mla(bf16_t* BQ, const bf16_t* BKN, const bf16_t* KR, bf16_t* BK, const float* gq, const float* gk, const f32x2* tabM, int gw, int NGW, int lane) {
    const int lh = lane >> 5, ll = lane & 31;
    const float gq0 = gq[ll], gq1 = gq[32 + ll], gq2 = gq[64 + ll], gk0 = gk[ll], gk1 = gk[32 + ll], gk2 = gk[64 + ll];
    unsigned short cq[4][3], ck[4][2], ckr, nq[4][3], nk[4][2], nkr;
#define PM_LOAD(t, Q, K_, KRV) do { _Pragma("unroll") for (int hp = 0; hp < 4; ++hp) { const int h = 2 * hp + lh; \
        const bf16_t* p = BQ + (size_t)(t) * 768 + h * 96; Q[hp][0] = p[ll]; Q[hp][1] = p[32 + ll]; Q[hp][2] = p[64 + ll]; \
        const bf16_t* kp = BKN + (size_t)(t) * 512 + h * 64; K_[hp][0] = kp[ll]; K_[hp][1] = kp[32 + ll]; } \
        KRV = KR[(size_t)(t) * 32 + ll]; } while (0)
    if (gw < TC) PM_LOAD(gw, cq, ck, ckr);
    for (int t = gw; t < TC; t += NGW) {
        if (t + NGW < TC) PM_LOAD(t + NGW, nq, nk, nkr);
        const int s = t & (SEQ - 1);
        const f32x2 cs = tabM[s * 16 + (ll & 15)];
        const float kr = bf2f(ckr);
#pragma unroll
        for (int hp = 0; hp < 4; ++hp) {
            const int h = 2 * hp + lh;
            {   bf16_t* p = BQ + (size_t)t * 768 + h * 96;
                const float q0 = bf2f(cq[hp][0]), q1 = bf2f(cq[hp][1]), q2 = bf2f(cq[hp][2]);
                const float rs = __builtin_amdgcn_rsqf(half_sum(q0 * q0 + q1 * q1 + q2 * q2) * (1.f / 96.f) + EPS);
                const float rq = rs * (0.10206207261596575f * LOG2E);
                const float y0 = q0 * rq * gq0, y1 = q1 * rq * gq1; float y2 = q2 * rq * gq2;
                const float pr = __shfl_xor(y2, 16);
                y2 = (ll < 16) ? (y2 * cs[0] - pr * cs[1]) : (y2 * cs[0] + pr * cs[1]);
                p[ll] = f2bf1(y0); p[32 + ll] = f2bf1(y1); p[64 + ll] = f2bf1(y2); }
            {   const float k0 = bf2f(ck[hp][0]), k1 = bf2f(ck[hp][1]);
                const float rs = __builtin_amdgcn_rsqf(half_sum(k0 * k0 + k1 * k1 + kr * kr) * (1.f / 96.f) + EPS);
                const float y0 = k0 * rs * gk0, y1 = k1 * rs * gk1; float y2 = kr * rs * gk2;
                const float pr = __shfl_xor(y2, 16);
                y2 = (ll < 16) ? (y2 * cs[0] - pr * cs[1]) : (y2 * cs[0] + pr * cs[1]);
                bf16_t* p = BK + (size_t)t * 768 + h * 96;
                p[ll] = f2bf1(y0); p[32 + ll] = f2bf1(y1); p[64 + ll] = f2bf1(y2); }
        }
#pragma unroll
        for (int hp = 0; hp < 4; ++hp) { cq[hp][0] = nq[hp][0]; cq[hp][1] = nq[hp][1]; cq[hp][2] = nq[hp][2]; ck[hp][0] = nk[hp][0]; ck[hp][1] = nk[hp][1]; }
        ckr = nkr;
    }
#undef PM_LOAD
}

#define MFMA32(a, b, c) __builtin_amdgcn_mfma_f32_32x32x16_bf16((a), (b), (c), 0, 0, 0)
__device__ __forceinline__ s16x8 ld8(const bf16_t* p) { return *(const s16x8*)p; }
__device__ __forceinline__ s16x8 ldv(const bf16_t* p) { const s16x4 a = *(const s16x4*)p, b = *(const s16x4*)(p + 8); return (s16x8){a[0], a[1], a[2], a[3], b[0], b[1], b[2], b[3]}; }
__device__ __forceinline__ s16x8 packp(const float* p) {
    const unsigned a = cvtpk(p[0], p[1]), b = cvtpk(p[2], p[3]), c = cvtpk(p[4], p[5]), d = cvtpk(p[6], p[7]);
    const u32x4v w = {a, b, c, d}; return __builtin_bit_cast(s16x8, w);
}
__device__ __forceinline__ void store_o(bf16_t* orow  , const f32x16& o0, const f32x16& o1, float inv, int hi) {
#pragma unroll
    for (int t = 0; t < 2; ++t)
#pragma unroll
        for (int jp = 0; jp < 4; jp += 2) {
            const f32x16& o = t == 0 ? o0 : o1;
            unsigned ax = cvtpk(o[4 * jp] * inv, o[4 * jp + 1] * inv), ay = cvtpk(o[4 * jp + 2] * inv, o[4 * jp + 3] * inv);
            unsigned bx = cvtpk(o[4 * jp + 4] * inv, o[4 * jp + 5] * inv), by = cvtpk(o[4 * jp + 6] * inv, o[4 * jp + 7] * inv);
            { const auto r = __builtin_amdgcn_permlane32_swap(ax, bx, false, false); ax = r[0]; bx = r[1]; }
            { const auto r = __builtin_amdgcn_permlane32_swap(ay, by, false, false); ay = r[0]; by = r[1]; }
            const u32x4v w = {ax, ay, bx, by};
            *(u32x4v*)(orow + 32 * t + 8 * jp + 8 * hi) = w;
        }
}
__device__ __forceinline__ void attn_B(const bf16_t* BQ, const bf16_t* BK, const bf16_t* BVt, bf16_t* OB, int bl, int h, int qt, int lane) {
    const int c = lane & 31, hi = lane >> 5;
    const size_t tb = (size_t)bl * SEQ;
    const bf16_t* qp = BQ + (tb + qt * 32 + c) * 768 + h * 96 + hi * 8;
    s16x8 qf[6];
#pragma unroll
    for (int kc = 0; kc < 6; ++kc) qf[kc] = ld8(qp + kc * 16);
    f32x16 o0, o1;
#pragma unroll
    for (int i = 0; i < 16; ++i) { o0[i] = 0.f; o1[i] = 0.f; }
    float m = -1e30f, l = 0.f;
    const float sc = 0.10206207261596575f * LOG2E;
    const int qpos = qt * 32 + c;
    const bf16_t* vbase = BVt + (size_t)(h * 64 + c) * TC + tb + 4 * hi;
    for (int kt = 0; kt <= qt; ++kt) {
        const bf16_t* kp = BK + (tb + kt * 32 + c) * 768 + h * 96 + hi * 8;
        f32x16 s;
#pragma unroll
        for (int i = 0; i < 16; ++i) s[i] = 0.f;
#pragma unroll
        for (int kc = 0; kc < 6; ++kc) s = MFMA32(ld8(kp + kc * 16), qf[kc], s);
        const s16x8 v00 = ldv(vbase + kt * 32), v01 = ldv(vbase + kt * 32 + 16), v10 = ldv(vbase + (size_t)32 * TC + kt * 32), v11 = ldv(vbase + (size_t)32 * TC + kt * 32 + 16);
        float p[16]; float mx = -1e30f;
#pragma unroll
        for (int i = 0; i < 16; ++i) { const int key = kt * 32 + 8 * (i >> 2) + 4 * hi + (i & 3); const float sv = (key <= qpos) ? s[i] * sc : -1e30f; p[i] = sv; mx = fmaxf(mx, sv); }
        mx = fmaxf(mx, __shfl_xor(mx, 32));
        const float mn = fmaxf(m, mx), alpha = fexp2(m - mn); m = mn;
        float ps = 0.f;
#pragma unroll
        for (int i = 0; i < 16; ++i) { p[i] = fexp2(p[i] - mn); ps += p[i]; }
        l = l * alpha + ps;
#pragma unroll
        for (int i = 0; i < 16; ++i) { o0[i] *= alpha; o1[i] *= alpha; }
        const s16x8 pf0 = packp(p), pf1 = packp(p + 8);
        o0 = MFMA32(v00, pf0, o0); o0 = MFMA32(v01, pf1, o0);
        o1 = MFMA32(v10, pf0, o1); o1 = MFMA32(v11, pf1, o1);
    }
    l += __shfl_xor(l, 32);
    store_o(OB + (tb + qpos) * 1280 + h * 64, o0, o1, 1.f / l, hi);
}
constexpr int KB_STR = 208, VB_STR = 136, KB_BYTES = 64 * KB_STR, VB_BYTES = 64 * VB_STR;
__device__ __forceinline__ s16x8 ldv_lds(const LAS unsigned char* p) { const s16x4 a = *(const LAS s16x4*)p, b = *(const LAS s16x4*)(p + 16); return (s16x8){a[0], a[1], a[2], a[3], b[0], b[1], b[2], b[3]}; }
__device__ __forceinline__ void attn_B_blk(const bf16_t* BQ, const bf16_t* BK, const bf16_t* BVt, bf16_t* OB, int bl, int h, int sq, LAS unsigned char* lds, int tid, int lane, int wave, const float sc) {
    const int c = lane & 31, hi = lane >> 5;
    const size_t tb = (size_t)bl * SEQ;
    const int qt = sq * 8 + wave, qpos = qt * 32 + c, nt = 4 * sq + 4, tlast = 4 * sq + (wave >> 1);
    const bf16_t* qp = BQ + (tb + qpos) * 768 + h * 96 + hi * 8;
    s16x8 qf[6];
#pragma unroll
    for (int kc = 0; kc < 6; ++kc) qf[kc] = ld8(qp + kc * 16);
    f32x16 o0, o1;
#pragma unroll
    for (int i = 0; i < 16; ++i) { o0[i] = 0.f; o1[i] = 0.f; }
    float m = -1e30f, l = 0.f;
    const int kr0 = tid / 12, kc0 = tid % 12, kr1 = (512 + tid) / 12, kc1 = (512 + tid) % 12, vr = tid >> 3, vc = tid & 7;
    const bf16_t* kg0 = BK + (tb + kr0) * 768 + h * 96 + kc0 * 8;
    const bf16_t* kg1 = BK + (tb + kr1) * 768 + h * 96 + kc1 * 8;
    const bf16_t* vg = BVt + (size_t)(h * 64 + vr) * TC + tb + vc * 8;
    LAS unsigned char* kl0 = lds + kr0 * KB_STR + kc0 * 16;
    LAS unsigned char* kl1 = lds + kr1 * KB_STR + kc1 * 16;
    LAS unsigned char* vl = lds + 2 * KB_BYTES + vr * VB_STR + vc * 16;
    u32x4v rk0, rk1, rv;
    rk1 = (u32x4v){0u, 0u, 0u, 0u};
#define B_LOAD(t) do { rk0 = *(const u32x4v*)(kg0 + (size_t)(t) * 64 * 768); if (tid < 256) rk1 = *(const u32x4v*)(kg1 + (size_t)(t) * 64 * 768); rv = *(const u32x4v*)(vg + (t) * 64); } while (0)
#define B_WRITE(b) do { *(LAS u32x4v*)(kl0 + (b) * KB_BYTES) = rk0; if (tid < 256) *(LAS u32x4v*)(kl1 + (b) * KB_BYTES) = rk1; \
        *(LAS u32x2*)(vl + (b) * VB_BYTES) = (u32x2){rv.x, rv.y}; *(LAS u32x2*)(vl + (b) * VB_BYTES + 8) = (u32x2){rv.z, rv.w}; } while (0)
    B_LOAD(0);
    B_WRITE(0);
    __syncthreads();
    if (nt > 1) B_LOAD(1);
    for (int t = 0; t < nt; ++t) {
        const int b = t & 1;
        if (t <= tlast) {
#pragma unroll
            for (int j = 0; j < 2; ++j) {
                const int key0 = t * 64 + j * 32;
                if (key0 <= qt * 32) {
                    const LAS unsigned char* kb = lds + b * KB_BYTES + (32 * j + c) * KB_STR + hi * 16;
                    f32x16 s;
#pragma unroll
                    for (int i = 0; i < 16; ++i) s[i] = 0.f;
#pragma unroll
                    for (int kc = 0; kc < 6; ++kc) s = MFMA32(*(const LAS s16x8*)(kb + kc * 32), qf[kc], s);
                    const LAS unsigned char* vb = lds + 2 * KB_BYTES + b * VB_BYTES + c * VB_STR + 64 * j + 8 * hi;
                    const s16x8 v00 = ldv_lds(vb), v01 = ldv_lds(vb + 32), v10 = ldv_lds(vb + 32 * VB_STR), v11 = ldv_lds(vb + 32 * VB_STR + 32);
                    float p[16]; float mx = -1e30f;
#pragma unroll
                    for (int i = 0; i < 16; ++i) { const int key = key0 + 8 * (i >> 2) + 4 * hi + (i & 3); const float sv = (key <= qpos) ? s[i] * sc : -1e30f; p[i] = sv; mx = fmaxf(mx, sv); }
                    mx = fmaxf(mx, __shfl_xor(mx, 32));
                    const float mn = fmaxf(m, mx), alpha = fexp2(m - mn); m = mn;
                    float ps = 0.f;
#pragma unroll
                    for (int i = 0; i < 16; ++i) { p[i] = fexp2(p[i] - mn); ps += p[i]; }
                    l = l * alpha + ps;
#pragma unroll
                    for (int i = 0; i < 16; ++i) { o0[i] *= alpha; o1[i] *= alpha; }
                    const s16x8 pf0 = packp(p), pf1 = packp(p + 8);
                    o0 = MFMA32(v00, pf0, o0); o0 = MFMA32(v01, pf1, o0);
                    o1 = MFMA32(v10, pf0, o1); o1 = MFMA32(v11, pf1, o1);
                }
            }
        }
        if (t + 1 < nt) B_WRITE(b ^ 1);
        __syncthreads();
        if (t + 2 < nt) B_LOAD(t + 2);
    }
#undef B_LOAD
#undef B_WRITE
    l += __shfl_xor(l, 32);
    store_o(OB + (tb + qpos) * 1280 + h * 64, o0, o1, 1.f / l, hi);
}
__device__ __forceinline__ void attn_C(const bf16_t* CQ, const bf16_t* CK, const bf16_t* CVt, bf16_t* OC, int bl, int h, int qt, int lane) {
    const int c = lane & 31, hi = lane >> 5;
    const size_t tb = (size_t)bl * SEQ;
    const bf16_t* qp = CQ + (tb + qt * 32 + c) * 512 + h * 64 + hi * 8;
    s16x8 qf[4];
#pragma unroll
    for (int kc = 0; kc < 4; ++kc) qf[kc] = ld8(qp + kc * 16);
    f32x16 o0, o1;
#pragma unroll
    for (int i = 0; i < 16; ++i) { o0[i] = 0.f; o1[i] = 0.f; }
    float carry = 0.f;
    const int qpos = qt * 32 + c;
    const bf16_t* vbase = CVt + (size_t)(h * 64 + c) * TC + tb + 4 * hi;
    for (int kt = qt; kt >= 0; --kt) {
        const bf16_t* kp = CK + (tb + kt * 32 + c) * 512 + h * 64 + hi * 8;
        f32x16 s;
#pragma unroll
        for (int i = 0; i < 16; ++i) s[i] = 0.f;
#pragma unroll
        for (int kc = 0; kc < 4; ++kc) s = MFMA32(ld8(kp + kc * 16), qf[kc], s);
        const s16x8 v00 = ldv(vbase + kt * 32), v01 = ldv(vbase + kt * 32 + 16), v10 = ldv(vbase + (size_t)32 * TC + kt * 32), v11 = ldv(vbase + (size_t)32 * TC + kt * 32 + 16);
        float lom[16], lw[16];
#pragma unroll
        for (int i = 0; i < 16; ++i) {
            const int key = kt * 32 + 8 * (i >> 2) + 4 * hi + (i & 3);
            const float z = s[i] * 0.125f;
            const float sp = fmaxf(z, 0.f) + LN2 * flog2(1.f + fexp2(-fabsf(z) * LOG2E));
            const bool valid = key < qpos;
            lom[i] = valid ? -sp : 0.f;
            lw[i] = valid ? (z - sp) : -1e30f;
        }
        float gs[4], pgs[4], suf[16];
#pragma unroll
        for (int j = 0; j < 4; ++j) {
            suf[4 * j + 3] = 0.f; suf[4 * j + 2] = lom[4 * j + 3]; suf[4 * j + 1] = suf[4 * j + 2] + lom[4 * j + 2]; suf[4 * j] = suf[4 * j + 1] + lom[4 * j + 1];
            gs[j] = suf[4 * j] + lom[4 * j];
            pgs[j] = __shfl_xor(gs[j], 32);
        }
        float T[4]; T[3] = 0.f; T[2] = gs[3] + pgs[3]; T[1] = T[2] + gs[2] + pgs[2]; T[0] = T[1] + gs[1] + pgs[1];
        const float total = T[0] + gs[0] + pgs[0];
        float p[16];
#pragma unroll
        for (int i = 0; i < 16; ++i) {
            const int j = i >> 2;
            const float after = carry + T[j] + (hi == 0 ? pgs[j] : 0.f) + suf[i];
            p[i] = fexp2((lw[i] + after) * LOG2E);
        }
        carry += total;
        const s16x8 pf0 = packp(p), pf1 = packp(p + 8);
        o0 = MFMA32(v00, pf0, o0); o0 = MFMA32(v01, pf1, o0);
        o1 = MFMA32(v10, pf0, o1); o1 = MFMA32(v11, pf1, o1);
        if (__builtin_amdgcn_ballot_w64(carry >= -104.f) == 0ull) break;
    }
    store_o(OC + (tb + qpos) * 1280 + h * 64, o0, o1, 1.f, hi);
}
constexpr int KB2_BYTES = 128 * KB_STR, VB2_STR = 264, VB2_BYTES = 64 * VB2_STR;
template <int OFF> __device__ __forceinline__ void kread6(s16x8 (&k)[6], unsigned addr) {
    asm volatile("ds_read_b128 %0, %1 offset:%2" : "=v"(k[0]) : "v"(addr), "i"(OFF));
    asm volatile("ds_read_b128 %0, %1 offset:%2" : "=v"(k[1]) : "v"(addr), "i"(OFF + 32));
    asm volatile("ds_read_b128 %0, %1 offset:%2" : "=v"(k[2]) : "v"(addr), "i"(OFF + 64));
    asm volatile("ds_read_b128 %0, %1 offset:%2" : "=v"(k[3]) : "v"(addr), "i"(OFF + 96));
    asm volatile("ds_read_b128 %0, %1 offset:%2" : "=v"(k[4]) : "v"(addr), "i"(OFF + 128));
    asm volatile("ds_read_b128 %0, %1 offset:%2" : "=v"(k[5]) : "v"(addr), "i"(OFF + 160));
}
__device__ __forceinline__ void kwait6(s16x8 (&k)[6]) { asm volatile("s_waitcnt lgkmcnt(0)" : "+v"(k[0]), "+v"(k[1]), "+v"(k[2]), "+v"(k[3]), "+v"(k[4]), "+v"(k[5])); }
__device__ __forceinline__ f32x16 qk96r(const s16x8 (&k)[6], const s16x8 (&qf)[6]) {
    f32x16 s;
#pragma unroll
    for (int i = 0; i < 16; ++i) s[i] = 0.f;
#pragma unroll
    for (int kc = 0; kc < 6; ++kc) s = MFMA32(k[kc], qf[kc], s);
    return s;
}
template <bool FAST> __device__ __forceinline__ void attn_B_blk2(const bf16_t* BQ, const bf16_t* BK, const bf16_t* BVt, bf16_t* OB, int bl, int h, int sq, LAS unsigned char* lds, int tid, int lane, int wave) {
    const int c = lane & 31, hi = lane >> 5;
    const size_t tb = (size_t)bl * SEQ;
    const int qt = sq * 8 + wave, qpos = qt * 32 + c, nt = 2 * sq + 2, tl = 2 * sq + (wave >> 2), jl = wave & 3;
    const bf16_t* qp = BQ + (tb + qpos) * 768 + h * 96 + hi * 8;
    s16x8 qf[6];
#pragma unroll
    for (int kc = 0; kc < 6; ++kc) qf[kc] = ld8(qp + kc * 16);
    f32x16 o0, o1;
#pragma unroll
    for (int i = 0; i < 16; ++i) { o0[i] = 0.f; o1[i] = 0.f; }
    float m = -1e30f, l = 0.f;
    const bf16_t* kg[3]; LAS unsigned char* kl[3];
#pragma unroll
    for (int i = 0; i < 3; ++i) { const int idx = tid + 512 * i, r = idx / 12, cc = idx - r * 12; kg[i] = BK + (tb + r) * 768 + h * 96 + cc * 8; kl[i] = lds + r * KB_STR + cc * 16; }
    const bf16_t* vg[2]; LAS unsigned char* vl[2];
#pragma unroll
    for (int i = 0; i < 2; ++i) { const int idx = tid + 512 * i, r = idx >> 4, cc = idx & 15; vg[i] = BVt + (size_t)(h * 64 + r) * TC + tb + cc * 8; vl[i] = lds + 2 * KB2_BYTES + r * VB2_STR + cc * 16; }
    u32x4v rk[3], rv[2];
#define B2_LOAD(t) do { _Pragma("unroll") for (int i_ = 0; i_ < 3; ++i_) rk[i_] = *(const u32x4v*)(kg[i_] + (size_t)(t) * 128 * 768); \
        _Pragma("unroll") for (int i_ = 0; i_ < 2; ++i_) rv[i_] = *(const u32x4v*)(vg[i_] + (t) * 128); } while (0)
#define B2_WRITE(b) do { _Pragma("unroll") for (int i_ = 0; i_ < 3; ++i_) *(LAS u32x4v*)(kl[i_] + (b) * KB2_BYTES) = rk[i_]; \
        _Pragma("unroll") for (int i_ = 0; i_ < 2; ++i_) { *(LAS u32x2*)(vl[i_] + (b) * VB2_BYTES) = (u32x2){rv[i_].x, rv[i_].y}; *(LAS u32x2*)(vl[i_] + (b) * VB2_BYTES + 8) = (u32x2){rv[i_].z, rv[i_].w}; } } while (0)
#define B2_SUB(J, KCUR, KNXT) if ((J) < nsub) { \
        f32x16 sn; \
        if ((J) + 1 < nsub) { kwait6(KNXT); sn = qk96r(KNXT, qf); } \
        if ((J) + 2 < nsub) kread6<((J) + 2) * 32 * KB_STR>(KCUR, kaddr); \
        const LAS unsigned char* vb = vb0 + 64 * (J); \
        const s16x8 v00 = ldv_lds(vb), v01 = ldv_lds(vb + 32), v10 = ldv_lds(vb + 32 * VB2_STR), v11 = ldv_lds(vb + 32 * VB2_STR + 32); \
        float p[16]; \
        if (FAST) { \
            if (t == tl && (J) == jl) { const int key0 = t * 128 + (J) * 32; \
                _Pragma("unroll") for (int i = 0; i < 16; ++i) { const int key = key0 + 8 * (i >> 2) + 4 * hi + (i & 3); p[i] = (key <= qpos) ? fexp2(s[i]) : 0.f; } \
            } else { _Pragma("unroll") for (int i = 0; i < 16; ++i) p[i] = fexp2(s[i]); } \
            float ps0 = 0.f, ps1 = 0.f; \
            _Pragma("unroll") for (int i = 0; i < 8; ++i) { ps0 += p[i]; ps1 += p[8 + i]; } \
            l += ps0 + ps1; \
        } else { \
            float mx = -1e30f; \
            if (t == tl && (J) == jl) { const int key0 = t * 128 + (J) * 32; \
                _Pragma("unroll") for (int i = 0; i < 16; ++i) { const int key = key0 + 8 * (i >> 2) + 4 * hi + (i & 3); const float sv = (key <= qpos) ? s[i] : -1e30f; p[i] = sv; mx = fmaxf(mx, sv); } \
            } else { _Pragma("unroll") for (int i = 0; i < 16; ++i) { p[i] = s[i]; mx = fmaxf(mx, s[i]); } } \
            mx = fmaxf(mx, __shfl_xor(mx, 32)); \
            const float mn = fmaxf(m, mx), alpha = fexp2(m - mn); \
            const bool moved = __builtin_amdgcn_ballot_w64(mn > m) != 0ull; \
            m = mn; \
            float ps = 0.f; \
            _Pragma("unroll") for (int i = 0; i < 16; ++i) { p[i] = fexp2(p[i] - mn); ps += p[i]; } \
            l = l * alpha + ps; \
            if (moved) { _Pragma("unroll") for (int i = 0; i < 16; ++i) { o0[i] *= alpha; o1[i] *= alpha; } } \
        } \
        const s16x8 pf0 = packp(p), pf1 = packp(p + 8); \
        o0 = MFMA32(v00, pf0, o0); o0 = MFMA32(v01, pf1, o0); \
        o1 = MFMA32(v10, pf0, o1); o1 = MFMA32(v11, pf1, o1); \
        if ((J) + 1 < nsub) s = sn; }
    B2_LOAD(0);
    B2_WRITE(0);
    __syncthreads();
    if (nt > 1) B2_LOAD(1);
    for (int t = 0; t < nt; ++t) {
        const int b = t & 1;
        const int nsub = t < tl ? 4 : (t == tl ? jl + 1 : 0);
        if (nsub > 0) {
            const unsigned kaddr = (unsigned)(unsigned long)(lds + b * KB2_BYTES + c * KB_STR + hi * 16);
            const LAS unsigned char* vb0 = lds + 2 * KB2_BYTES + b * VB2_BYTES + c * VB2_STR + 8 * hi;
            s16x8 ka[6], kb_[6];
            kread6<0>(ka, kaddr);
            kwait6(ka);
            f32x16 s = qk96r(ka, qf);
            if (nsub > 1) kread6<32 * KB_STR>(kb_, kaddr);
            B2_SUB(0, ka, kb_)
            B2_SUB(1, kb_, ka)
            B2_SUB(2, ka, kb_)
            B2_SUB(3, kb_, ka)
        }
        if (t + 1 < nt) B2_WRITE(b ^ 1);
        __syncthreads();
        if (t + 2 < nt) B2_LOAD(t + 2);
    }
#undef B2_SUB
#undef B2_LOAD
#undef B2_WRITE
    l += __shfl_xor(l, 32);
    store_o(OB + (tb + qpos) * 1280 + h * 64, o0, o1, 1.f / l, hi);
}
constexpr int KC_STR = 144, KC_BYTES = 64 * KC_STR;
__device__ __forceinline__ void attn_C_blk(const bf16_t* CQ, const bf16_t* CK, const bf16_t* CVt, bf16_t* OC, int bl, int h, int sq, LAS unsigned char* lds, int tid, int lane, int wave) {
    const int c = lane & 31, hi = lane >> 5;
    const size_t tb = (size_t)bl * SEQ;
    const int qt = sq * 8 + wave, qpos = qt * 32 + c, nt = 4 * sq + 4, tlast = 4 * sq + (wave >> 1);
    const bf16_t* qp = CQ + (tb + qpos) * 512 + h * 64 + hi * 8;
    s16x8 qf[4];
#pragma unroll
    for (int kc = 0; kc < 4; ++kc) qf[kc] = ld8(qp + kc * 16);
    f32x16 o0, o1;
#pragma unroll
    for (int i = 0; i < 16; ++i) { o0[i] = 0.f; o1[i] = 0.f; }
    float carry = 0.f; bool done = false;
    const int kr = tid >> 3, kc8 = tid & 7;
    const bf16_t* kg = CK + (tb + kr) * 512 + h * 64 + kc8 * 8;
    const bf16_t* vg = CVt + (size_t)(h * 64 + kr) * TC + tb + kc8 * 8;
    LAS unsigned char* kl = lds + kr * KC_STR + kc8 * 16;
    LAS unsigned char* vl = lds + 2 * KC_BYTES + kr * VB_STR + kc8 * 16;
    volatile LAS unsigned* fl = (volatile LAS unsigned*)(lds + 2 * KC_BYTES + 2 * VB_BYTES);
    if (tid < 3) fl[tid] = 0u;
    u32x4v rk, rv;
#define C_LOAD(t) do { rk = *(const u32x4v*)(kg + (size_t)(t) * 64 * 512); rv = *(const u32x4v*)(vg + (t) * 64); } while (0)
#define C_WRITE(b) do { *(LAS u32x4v*)(kl + (b) * KC_BYTES) = rk; *(LAS u32x2*)(vl + (b) * VB_BYTES) = (u32x2){rv.x, rv.y}; *(LAS u32x2*)(vl + (b) * VB_BYTES + 8) = (u32x2){rv.z, rv.w}; } while (0)
    C_LOAD(nt - 1);
    C_WRITE(0);
    __syncthreads();
    if (nt > 1) C_LOAD(nt - 2);
    for (int it = 0; it < nt; ++it) {
        const int t = nt - 1 - it, b = it & 1;
        if (!done && t <= tlast) {
#pragma unroll
            for (int jj = 0; jj < 2; ++jj) {
                const int j = 1 - jj, key0 = t * 64 + j * 32;
                if (key0 <= qt * 32 && !done) {
                    const LAS unsigned char* kb = lds + b * KC_BYTES + (32 * j + c) * KC_STR + hi * 16;
                    f32x16 s;
#pragma unroll
                    for (int i = 0; i < 16; ++i) s[i] = 0.f;
#pragma unroll
                    for (int kc = 0; kc < 4; ++kc) s = MFMA32(*(const LAS s16x8*)(kb + kc * 32), qf[kc], s);
                    const LAS unsigned char* vb = lds + 2 * KC_BYTES + b * VB_BYTES + c * VB_STR + 64 * j + 8 * hi;
                    const s16x8 v00 = ldv_lds(vb), v01 = ldv_lds(vb + 32), v10 = ldv_lds(vb + 32 * VB_STR), v11 = ldv_lds(vb + 32 * VB_STR + 32);
                    float lom[16], lw[16];
#pragma unroll
                    for (int i = 0; i < 16; ++i) {
                        const int key = key0 + 8 * (i >> 2) + 4 * hi + (i & 3);
                        const float z = s[i] * 0.125f;
                        const float sp = fmaxf(z, 0.f) + LN2 * flog2(1.f + fexp2(-fabsf(z) * LOG2E));
                        const bool valid = key < qpos;
                        lom[i] = valid ? -sp : 0.f;
                        lw[i] = valid ? (z - sp) : -1e30f;
                    }
                    float gs[4], pgs[4], suf[16];
#pragma unroll
                    for (int jg = 0; jg < 4; ++jg) {
                        suf[4 * jg + 3] = 0.f; suf[4 * jg + 2] = lom[4 * jg + 3]; suf[4 * jg + 1] = suf[4 * jg + 2] + lom[4 * jg + 2]; suf[4 * jg] = suf[4 * jg + 1] + lom[4 * jg + 1];
                        gs[jg] = suf[4 * jg] + lom[4 * jg];
                        pgs[jg] = lane_x32(gs[jg], hi);
                    }
                    float T[4]; T[3] = 0.f; T[2] = gs[3] + pgs[3]; T[1] = T[2] + gs[2] + pgs[2]; T[0] = T[1] + gs[1] + pgs[1];
                    const float total = T[0] + gs[0] + pgs[0];
                    float p[16];
#pragma unroll
                    for (int i = 0; i < 16; ++i) {
                        const int jg = i >> 2;
                        const float after = carry + T[jg] + (hi == 0 ? pgs[jg] : 0.f) + suf[i];
                        p[i] = fexp2((lw[i] + after) * LOG2E);
                    }
                    carry += total;
                    const s16x8 pf0 = packp(p), pf1 = packp(p + 8);
                    o0 = MFMA32(v00, pf0, o0); o0 = MFMA32(v01, pf1, o0);
                    o1 = MFMA32(v10, pf0, o1); o1 = MFMA32(v11, pf1, o1);
                    done = (__builtin_amdgcn_ballot_w64(carry >= -104.f) == 0ull);
                }
            }
        }
        if (it + 1 < nt) C_WRITE(b ^ 1);
        if (!done && lane == 0) fl[it % 3] = 1u;
        if (tid == 0) fl[(it + 1) % 3] = 0u;
        __syncthreads();
        if (fl[it % 3] == 0u) break;
        if (it + 2 < nt) C_LOAD(t - 2);
    }
#undef C_LOAD
#undef C_WRITE
    store_o(OC + (tb + qpos) * 1280 + h * 64, o0, o1, 1.f, hi);
}
constexpr int VA_STR = 776, KA_BYTES = 384 * KC_STR;
__device__ __forceinline__ void attn_A_blk(const bf16_t* AQ, const bf16_t* AK, const bf16_t* AVt, bf16_t* OG, float* LSE, int bl, int head, int rc, int chunk, LAS unsigned char* lds, int tid, int lane, int wave) {
    const int c = lane & 31, hi = lane >> 5, g2 = (head >> 2) * 2, L = SEQ >> g2;
    const size_t tb = (size_t)bl * SEQ;
    const int u0 = chunk * 256, kbase = u0 - 128;
    {   u32x4v rk[6], rv[6];
#pragma unroll
        for (int i = 0; i < 6; ++i) {
            const int idx = tid + 512 * i, row = idx >> 3, cc = idx & 7; int uk = kbase + row; uk = uk < 0 ? 0 : uk;
            rk[i] = *(const u32x4v*)(AK + (tb + ((size_t)uk << g2) + rc) * 768 + head * 64 + cc * 8);
            const int vrow = idx / 48, vcc = idx - vrow * 48; int uv = kbase + 8 * vcc; uv = uv < 0 ? 0 : uv;
            rv[i] = *(const u32x4v*)(AVt + (size_t)(head * 64 + vrow) * TC + tb + (size_t)rc * L + uv);
        }
#pragma unroll
        for (int i = 0; i < 6; ++i) {
            const int idx = tid + 512 * i, row = idx >> 3, cc = idx & 7;
            *(LAS u32x4v*)(lds + row * KC_STR + cc * 16) = rk[i];
            const int vrow = idx / 48, vcc = idx - vrow * 48;
            LAS unsigned char* vp = lds + KA_BYTES + vrow * VA_STR + vcc * 16;
            *(LAS u32x2*)vp = (u32x2){rv[i].x, rv[i].y}; *(LAS u32x2*)(vp + 8) = (u32x2){rv[i].z, rv[i].w};
        }
    }
    const int uq = u0 + 32 * wave + c;
    const size_t tq = ((size_t)uq << g2) + rc;
    const bf16_t* qp = AQ + (tb + tq) * 768 + head * 64 + hi * 8;
    s16x8 qf[4];
#pragma unroll
    for (int kc = 0; kc < 4; ++kc) qf[kc] = ld8(qp + kc * 16);
    f32x16 o0, o1;
#pragma unroll
    for (int i = 0; i < 16; ++i) { o0[i] = 0.f; o1[i] = 0.f; }
    float m = -1e30f, l = 0.f;
    const float sc = 0.125f * LOG2E;
    __syncthreads();
    for (int j = 0; j < 5; ++j) {
        const int r0 = 32 * wave + 32 * j, kt0 = kbase + r0;
        if (kt0 + 31 < 0) continue;
        const LAS unsigned char* kb = lds + (r0 + c) * KC_STR + hi * 16;
        f32x16 s;
#pragma unroll
        for (int i = 0; i < 16; ++i) s[i] = 0.f;
#pragma unroll
        for (int kc = 0; kc < 4; ++kc) s = MFMA32(*(const LAS s16x8*)(kb + kc * 32), qf[kc], s);
        const LAS unsigned char* vb = lds + KA_BYTES + c * VA_STR + r0 * 2 + 8 * hi;
        const s16x8 v00 = ldv_lds(vb), v01 = ldv_lds(vb + 32), v10 = ldv_lds(vb + 32 * VA_STR), v11 = ldv_lds(vb + 32 * VA_STR + 32);
        float p[16]; float mx = -1e30f; unsigned vmask = 0u;
#pragma unroll
        for (int i = 0; i < 16; ++i) {
            const int uk = kt0 + 8 * (i >> 2) + 4 * hi + (i & 3), dist = uq - uk;
            const bool valid = (dist >= 0) && (dist <= 128) && (uk >= 0);
            const float sv = valid ? s[i] * sc : -1e30f; p[i] = sv; mx = fmaxf(mx, sv); vmask |= valid ? (1u << i) : 0u;
        }
        mx = fmaxf(mx, lane_x32(mx, hi));
        const float mn = fmaxf(m, mx), alpha = fexp2(m - mn); m = mn;
        float ps = 0.f;
#pragma unroll
        for (int i = 0; i < 16; ++i) { p[i] = ((vmask >> i) & 1u) ? fexp2(p[i] - mn) : 0.f; ps += p[i]; }
        l = l * alpha + ps;
#pragma unroll
        for (int i = 0; i < 16; ++i) { o0[i] *= alpha; o1[i] *= alpha; }
        const s16x8 pf0 = packp(p), pf1 = packp(p + 8);
        o0 = MFMA32(v00, pf0, o0); o0 = MFMA32(v01, pf1, o0);
        o1 = MFMA32(v10, pf0, o1); o1 = MFMA32(v11, pf1, o1);
    }
    l += __shfl_xor(l, 32);
    store_o(OG + (tb + tq) * 768 + head * 64, o0, o1, 1.f / l, hi);
    if (hi == 0) LSE[(tb + tq) * 12 + head] = m + flog2(l);
}
__device__ __forceinline__ void combine_A(const bf16_t* OG, const float* LSE, bf16_t* OA, int gw, int NGW, int lane) {
    const int slot = lane >> 4, d4 = (lane & 15) * 4;
    float cl[3], nl[3]; u32x2 co[3], no[3];
#define CA_LOAD(t, L_, O_) do { _Pragma("unroll") for (int g = 0; g < 3; ++g) { L_[g] = LSE[(size_t)(t) * 12 + 4 * g + slot]; O_[g] = *(const u32x2*)(OG + (size_t)(t) * 768 + g * 256 + slot * 64 + d4); } } while (0)
    if (gw < TC) CA_LOAD(gw, cl, co);
    for (int t = gw; t < TC; t += NGW) {
        if (t + NGW < TC) CA_LOAD(t + NGW, nl, no);
        const float mx = fmaxf(cl[0], fmaxf(cl[1], cl[2]));
        const float w0 = fexp2(cl[0] - mx), w1 = fexp2(cl[1] - mx), w2 = fexp2(cl[2] - mx), inv = 1.f / (w0 + w1 + w2);
        const u32x2 a = co[0], b = co[1], cc = co[2];
        float r[4];
        r[0] = (w0 * __builtin_bit_cast(float, a.x << 16) + w1 * __builtin_bit_cast(float, b.x << 16) + w2 * __builtin_bit_cast(float, cc.x << 16)) * inv;
        r[1] = (w0 * __builtin_bit_cast(float, a.x & 0xffff0000u) + w1 * __builtin_bit_cast(float, b.x & 0xffff0000u) + w2 * __builtin_bit_cast(float, cc.x & 0xffff0000u)) * inv;
        r[2] = (w0 * __builtin_bit_cast(float, a.y << 16) + w1 * __builtin_bit_cast(float, b.y << 16) + w2 * __builtin_bit_cast(float, cc.y << 16)) * inv;
        r[3] = (w0 * __builtin_bit_cast(float, a.y & 0xffff0000u) + w1 * __builtin_bit_cast(float, b.y & 0xffff0000u) + w2 * __builtin_bit_cast(float, cc.y & 0xffff0000u)) * inv;
        u32x2 w; w.x = cvtpk(r[0], r[1]); w.y = cvtpk(r[2], r[3]);
        *(u32x2*)(OA + (size_t)t * 1280 + slot * 64 + d4) = w;
#pragma unroll
        for (int g = 0; g < 3; ++g) { cl[g] = nl[g]; co[g] = no[g]; }
    }
#undef CA_LOAD
}
__device__ __forceinline__ void attn_A(const bf16_t* AQ, const bf16_t* AK, const bf16_t* AVt, bf16_t* OA, int bl, int slot, int r, int ut, int lane) {
    const int c = lane & 31, hi = lane >> 5;
    const size_t tb = (size_t)bl * SEQ;
    const int tq = 16 * (32 * ut + c) + r;
    f32x16 o0, o1;
#pragma unroll
    for (int i = 0; i < 16; ++i) { o0[i] = 0.f; o1[i] = 0.f; }
    float m = -1e30f, l = 0.f;
    const float sc = 0.125f * LOG2E;
#pragma unroll
    for (int g = 0; g < 3; ++g) {
        const int d = g == 0 ? 1 : (g == 1 ? 4 : 16), L = SEQ / d, qs = 16 / d;
        const int rc = r % d, uq0 = (512 * ut + r) / d, uq = uq0 + c * qs, head = g * 4 + slot;
        const bf16_t* qp = AQ + (tb + tq) * 768 + head * 64 + hi * 8;
        s16x8 qf[4];
#pragma unroll
        for (int kc = 0; kc < 4; ++kc) qf[kc] = ld8(qp + kc * 16);
        const int klo = (uq0 > 128 ? uq0 - 128 : 0) & ~31, khi = uq0 + 31 * qs;
        const bf16_t* vbase = AVt + (size_t)(head * 64 + c) * TC + tb + (size_t)rc * L + 4 * hi;
        for (int k0 = klo; k0 <= khi; k0 += 32) {
            const bf16_t* kp = AK + (tb + (size_t)(k0 + c) * d + rc) * 768 + head * 64 + hi * 8;
            f32x16 s;
#pragma unroll
            for (int i = 0; i < 16; ++i) s[i] = 0.f;
#pragma unroll
            for (int kc = 0; kc < 4; ++kc) s = MFMA32(ld8(kp + kc * 16), qf[kc], s);
            const s16x8 v00 = ldv(vbase + k0), v01 = ldv(vbase + k0 + 16), v10 = ldv(vbase + (size_t)32 * TC + k0), v11 = ldv(vbase + (size_t)32 * TC + k0 + 16);
            float p[16]; float mx = -1e30f; unsigned vmask = 0u;
#pragma unroll
            for (int i = 0; i < 16; ++i) {
                const int uk = k0 + 8 * (i >> 2) + 4 * hi + (i & 3), dist = uq - uk;
                const bool valid = (dist >= 0) && (dist <= 128);
                const float sv = valid ? s[i] * sc : -1e30f; p[i] = sv; mx = fmaxf(mx, sv); vmask |= valid ? (1u << i) : 0u;
            }
            mx = fmaxf(mx, __shfl_xor(mx, 32));
            const float mn = fmaxf(m, mx), alpha = fexp2(m - mn); m = mn;
            float ps = 0.f;
#pragma unroll
            for (int i = 0; i < 16; ++i) { p[i] = ((vmask >> i) & 1u) ? fexp2(p[i] - mn) : 0.f; ps += p[i]; }
            l = l * alpha + ps;
#pragma unroll
            for (int i = 0; i < 16; ++i) { o0[i] *= alpha; o1[i] *= alpha; }
            const s16x8 pf0 = packp(p), pf1 = packp(p + 8);
            o0 = MFMA32(v00, pf0, o0); o0 = MFMA32(v01, pf1, o0);
            o1 = MFMA32(v10, pf0, o1); o1 = MFMA32(v11, pf1, o1);
        }
    }
    l += __shfl_xor(l, 32);
    store_o(OA + (tb + tq) * 256 + slot * 64, o0, o1, 1.f / l, hi);
}

#define XB_TMO      128
#define XB_XCNT(j)  (256  + 64 * (j))
#define XB_XSUB(j)  (1280 + 64 * (j))
#define XB_XGEN(j)  (2304 + 64 * (j))
#define XB_TOP      3328
#define XB_TOPGEN   3392
#define XCD_BAR_WORDS 3456
#define XB_SPIN_CAP (1u << 18)

__device__ __forceinline__ unsigned xb_ld(unsigned* p)              { return __hip_atomic_load(p, __ATOMIC_RELAXED, __HIP_MEMORY_SCOPE_AGENT); }
__device__ __forceinline__ unsigned xb_add(unsigned* p, unsigned v) { return __hip_atomic_fetch_add(p, v, __ATOMIC_RELAXED, __HIP_MEMORY_SCOPE_AGENT); }
__device__ __forceinline__ unsigned xb_xcc_id() { return (unsigned)__builtin_amdgcn_s_getreg((3 << 11) | 20) & 0xFu; }
#define XB_SPIN(cond, bar) do { unsigned _sp = 0; while (cond) { __builtin_amdgcn_s_sleep(1); \
    if ((++_sp & 255u) == 0u) { if (xb_ld(&(bar)[XB_TMO])) break; if (_sp > XB_SPIN_CAP) { atomicAdd(&(bar)[XB_TMO], 1u); break; } } } } while (0)

struct XcdBarrier {
    unsigned* bar; unsigned x;
    volatile LAS unsigned* st;
};

__device__ __forceinline__ XcdBarrier xcd_barrier_post(unsigned* bar, volatile LAS unsigned* st) {
    XcdBarrier b; b.bar = bar; b.x = xb_xcc_id(); b.st = st;
    if (threadIdx.x == 0) (void)xb_add(&bar[XB_XCNT(b.x)], 1u);
    return b;
}
__device__ __forceinline__ void xcd_barrier_complete(unsigned* bar, unsigned x, unsigned& nloc, unsigned& nx) {
    const unsigned G = gridDim.x * gridDim.y * gridDim.z;
    unsigned sum, cnt, mine, sp = 0u;
    for (;;) {
        sum = 0u; cnt = 0u; mine = 0u;
#pragma unroll
        for (unsigned j = 0; j < 16; ++j) { const unsigned c = xb_ld(&bar[XB_XCNT(j)]); sum += c; cnt += (c > 0u) ? 1u : 0u; mine = (j == x) ? c : mine; }
        if (sum == G) break;
        __builtin_amdgcn_s_sleep(1);
        if ((++sp & 255u) == 0u) { if (xb_ld(&bar[XB_TMO])) break; if (sp > XB_SPIN_CAP) { atomicAdd(&bar[XB_TMO], 1u); break; } }
    }
    nloc = mine > 0u ? mine : 1u; nx = cnt > 0u ? cnt : 1u;
}

__device__ __forceinline__ void xcd_barrier(const XcdBarrier& b) {
    asm volatile("s_waitcnt vmcnt(0)" ::: "memory");
    __syncthreads();
    if (threadIdx.x == 0) {
        unsigned* bar = b.bar;
        __builtin_amdgcn_s_waitcnt(0);
        unsigned nloc = b.st[0], nx = b.st[1];
        if (nloc == 0u) { xcd_barrier_complete(bar, b.x, nloc, nx); b.st[0] = nloc; b.st[1] = nx; }
        const unsigned old = xb_add(&bar[XB_XSUB(b.x)], 1u);
        const unsigned gen = old / nloc;
        if (old + 1u == (gen + 1u) * nloc) {
            __builtin_amdgcn_fence(__ATOMIC_RELEASE, "agent");
            asm volatile("s_waitcnt vmcnt(0)" ::: "memory");
            const unsigned og = xb_add(&bar[XB_TOP], 1u);
            const unsigned tg = og / nx;
            if (og + 1u == (tg + 1u) * nx) xb_add(&bar[XB_TOPGEN], 1u);
            else XB_SPIN(xb_ld(&bar[XB_TOPGEN]) == tg, bar);
            __builtin_amdgcn_fence(__ATOMIC_ACQUIRE, "agent");
            xb_add(&bar[XB_XGEN(b.x)], 1u);
            asm volatile("s_waitcnt vmcnt(0)" ::: "memory");
        } else {
            XB_SPIN(xb_ld(&bar[XB_XGEN(b.x)]) == gen, bar);
            __builtin_amdgcn_fence(__ATOMIC_ACQUIRE, "agent");
            asm volatile("s_waitcnt vmcnt(0)" ::: "memory");
        }
    }
    __syncthreads();
}

#ifndef PHMASK
#define PHMASK 0xFFFF
#endif
#define PH(k) if constexpr ((PHMASK >> (k)) & 1)
__global__ void __launch_bounds__(512, 2) mega_fwd(Args a) {
    extern __shared__ __attribute__((aligned(16))) unsigned char lds_raw[];
    LAS unsigned char* lds = (LAS unsigned char*)lds_raw;
    volatile LAS unsigned* shq = (volatile LAS unsigned*)(lds + 131072);
    cg::grid_group grid = cg::this_grid();
    if (threadIdx.x < 2) ((volatile LAS unsigned*)(lds + 131072 + 256))[threadIdx.x] = 0u;
    __syncthreads();
    const int tid = threadIdx.x, lane = tid & 63, wave = __builtin_amdgcn_readfirstlane(tid >> 6);
    const int G = (int)gridDim.x, gw = (int)blockIdx.x * 8 + wave, NGW = G * 8;
    unsigned char* ws = a.ws;
    unsigned* ctr = (unsigned*)(ws + O_CTL);
    f32x2* tabA = (f32x2*)(ws + O_TABA); f32x2* tabM = (f32x2*)(ws + O_TABM);

    {
        LAS float* scr = (LAS float*)(lds + wave * 16384);
        unsigned ib = 0u;
        for (int l = 0; l < DEPTH; ++l) {
            const float* win = a.in[2] + (size_t)l * 1024 * INC; bf16_t* wt = (bf16_t*)(ws + O_WIN + l * S_WIN);
            for (int hb = 0; hb < 48; ++hb) {
                const int isk = hb >= 24, hd = (hb % 24) >> 1, bj = hb & 1;
                tr_seg(win, INC, 1024, isk * 768 + hd * 64 + 32 * bj, 32, wt, isk * 768 + (hd >> 2) * 256 + 128 * bj + 32 * (hd & 3), scr, gw, NGW, lane, ib);
            }
            tr_seg(win, INC, 1024, 2304, 256, wt, 1536, scr, gw, NGW, lane, ib);
            tr_seg(win, INC, 1024, 2560, 160, wt, 1792, scr, gw, NGW, lane, ib);
            tr_seg(win, INC, 1024, 2720, 512, wt, 2048, scr, gw, NGW, lane, ib);
            tr_seg(win, INC, 1024, 3232, 512, wt, 2560, scr, gw, NGW, lane, ib);
            tr_seg(win, INC, 1024, 4256, 3072, wt, 3072, scr, gw, NGW, lane, ib);
            tr_seg(win, INC, 1024, 1536, 768, wt, 6144, scr, gw, NGW, lane, ib);
            tr_seg(win, INC, 1024, 3744, 512, wt, 6912, scr, gw, NGW, lane, ib);
            tr_seg(a.in[6] + (size_t)l * 256 * 768, 768, 256, 0, 768, (bf16_t*)(ws + O_WQB + l * S_WQB), 0, scr, gw, NGW, lane, ib, a.in[5] + l * 256);
            for (int h = 0; h < 8; ++h) {
                tr_seg(a.in[8] + (size_t)l * 128 * 1024, 1024, 128, h * 128, 64, (bf16_t*)(ws + O_WKVB + l * S_WKVB), h * 64, scr, gw, NGW, lane, ib, a.in[7] + l * 128);
                tr_seg(a.in[8] + (size_t)l * 128 * 1024, 1024, 128, h * 128 + 64, 64, (bf16_t*)(ws + O_WKVB + l * S_WKVB), 512 + h * 64, scr, gw, NGW, lane, ib, a.in[7] + l * 128);
            }
            const float* wb = a.in[11] + (size_t)l * 1280 * 1024;
            { bf16_t* wbt = (bf16_t*)(ws + O_WBRA + l * S_WBR);
              tr_seg(wb, 1024, 256, 0, 1024, wbt, 0, scr, gw, NGW, lane, ib, nullptr, 1280, 0);
              tr_seg(wb + (size_t)256 * 1024, 1024, 512, 0, 1024, wbt, 0, scr, gw, NGW, lane, ib, nullptr, 1280, 256);
              tr_seg(wb + (size_t)768 * 1024, 1024, 512, 0, 1024, wbt, 0, scr, gw, NGW, lane, ib, nullptr, 1280, 768); }
            tr_seg(a.in[12] + (size_t)l * 1024 * 1024, 1024, 1024, 0, 1024, (bf16_t*)(ws + O_WOUT + l * S_WOUT), 0, scr, gw, NGW, lane, ib);
            tr_seg(a.in[14] + (size_t)l * 1024 * 4096, 4096, 1024, 0, 4096, (bf16_t*)(ws + O_W1 + l * S_W1), 0, scr, gw, NGW, lane, ib);
            tr_seg(a.in[15] + (size_t)l * 4096 * 1024, 1024, 4096, 0, 1024, (bf16_t*)(ws + O_W2 + l * S_W1), 0, scr, gw, NGW, lane, ib);
        }
        {   volatile LAS float* fq = (volatile LAS float*)(lds + 131072 + 64);
            if (tid == 0) {
#pragma unroll
                for (int j = 0; j < 8; ++j) fq[j] = a.invfA[j];
#pragma unroll
                for (int j = 0; j < 16; ++j) fq[8 + j] = a.invfM[j];
            }
            __syncthreads();
        }
        for (int i = (int)blockIdx.x * 512 + tid; i < SEQ * 24; i += G * 512) {
            const int s = i / 24, j = i % 24;
            const float invf = ((volatile LAS float*)(lds + 131072 + 64))[j];
            const float ang = (float)s * invf;
            const double rev = (double)ang * 0.15915494309189535;
            const float fr = (float)(rev - __builtin_floor(rev));
            f32x2 cs; cs[0] = __builtin_amdgcn_cosf(fr); cs[1] = __builtin_amdgcn_sinf(fr);
            if (j < 8) tabA[s * 8 + j] = cs; else tabM[s * 16 + (j - 8)] = cs;
        }
        if (blockIdx.x == 0) { if (tid < 256) ctr[tid] = 0u; unsigned* bw = (unsigned*)(ws + O_BAR); for (int i = tid; i < XCD_BAR_WORDS; i += 512) bw[i] = 0u; }
    }
    grid.sync();
    const XcdBarrier xbar = xcd_barrier_post((unsigned*)(ws + O_BAR), (volatile LAS unsigned*)(lds + 131072 + 256));

#define GAS __attribute__((address_space(1)))
#define INP(k) ({ uintptr_t _p = (uintptr_t)a.in[k]; asm volatile("" : "+s"(_p)); (const float*)(const GAS float*)_p; })
#ifdef PROBE_MASK
    constexpr int NST = 14 + __builtin_popcount(PROBE_MASK);
#else
    constexpr int NST = 14;
#endif
    for (int step = 0; step < NCHUNK * DEPTH * NST; ++step) {
        const int inst = step / NST, l = inst & (DEPTH - 1), ch = inst / DEPTH;
        int ri = step - inst * NST, rep = 0;
#ifdef PROBE_MASK
        {   int k = 0, found = 0;
#pragma unroll
            for (int sx = 0; sx < 14; ++sx) { if (k == ri) { found = sx; rep = 0; } ++k; if ((PROBE_MASK >> sx) & 1) { if (k == ri) { found = sx; rep = 1; } ++k; } }
            ri = found; }
#endif
        const int st = ri <= 2 ? ri : (ri <= 7 ? ri + 1 : (ri == 8 ? 16 : (ri == 9 ? 9 : ri + 2)));
        const size_t tok0 = (size_t)ch * TC;
        uintptr_t wsi = (uintptr_t)a.ws; asm volatile("" : "+s"(wsi));
        unsigned char* wsl = (unsigned char*)(GAS unsigned char*)wsi;
        uintptr_t outi = (uintptr_t)a.out; asm volatile("" : "+s"(outi));
        float* outl = (float*)(GAS float*)outi;
        int tidl = tid; asm volatile("" : "+v"(tidl));
        const int lanel = tidl & 63;
        int wavel = wave; asm volatile("" : "+s"(wavel));
        const int gwl = (int)blockIdx.x * 8 + wavel;
        const float* xsrc = (l == 0 ? INP(0) : (const float*)outl) + tok0 * 1024;
        float* xdst = outl + tok0 * 1024;
        bool sync = true;
        const bool is_gemm = (st == 1 || st == 2 || st == 4 || st == 5 || st == 6 || st == 9 || st == 12 || st == 14 || st == 15);
        if (is_gemm) {
            const bf16_t* A; const bf16_t* Bt; int M, N, K; EpiDyn E{wsl, M_RES, xdst, xdst, nullptr, nullptr};
            const bf16_t* win = (const bf16_t*)(wsl + O_WIN + l * S_WIN);
            const bf16_t* wkvb = (const bf16_t*)(wsl + O_WKVB + l * S_WKVB);
            switch (st) {
            case 1: A = (const bf16_t*)(wsl + O_XN); Bt = win; M = TC; N = NPROJ; K = 1024; E.mode = M_PROJ; E.g0 = INP(3) + l * 64; E.g1 = INP(4) + l * 64; sync = false; break;
            case 2: A = win + (size_t)NPROJ * 1024; Bt = (const bf16_t*)(wsl + O_XN); M = NSWV; N = TC; K = 1024; E.mode = M_SWAPV; break;
            case 4: A = (const bf16_t*)(wsl + O_BQL); Bt = (const bf16_t*)(wsl + O_WQB + l * S_WQB); M = TC; N = 768; K = 256; E.mode = M_BQ; sync = false; break;
            case 5: A = (const bf16_t*)(wsl + O_KVAN); Bt = wkvb; M = TC; N = 512; K = 128; E.mode = M_BKN; sync = false; break;
            case 6: A = wkvb + (size_t)512 * 128; Bt = (const bf16_t*)(wsl + O_KVAN); M = 512; N = TC; K = 128; E.mode = M_BVT; break;
            case 9: A = (const bf16_t*)(wsl + O_OA); Bt = (const bf16_t*)(wsl + O_WBRA + l * S_WBR); M = TC; N = 1024; K = 1280; E.mode = M_GCAT; break;
            case 12: A = (const bf16_t*)(wsl + O_XN); Bt = (const bf16_t*)(wsl + O_WOUT + l * S_WOUT); M = TC; N = 1024; K = 1024; E.mode = M_RES; E.rbase = xsrc; break;
            case 14: A = (const bf16_t*)(wsl + O_XN); Bt = (const bf16_t*)(wsl + O_W1 + l * S_W1); M = TC; N = 4096; K = 1024; E.mode = M_U; break;
            default: A = (const bf16_t*)(wsl + O_U); Bt = (const bf16_t*)(wsl + O_W2 + l * S_W1); M = TC; N = 1024; K = 4096; E.mode = M_RES; break;
            }
            pg8::Gemm g{A, Bt, M, N, K, (E.mode == M_SWAPV) ? 1 : 0}; pg8::StaticOrder S; S.init(M, N, G, (int)blockIdx.x);
            pg8::gemm_phase<EpiDyn, pg8::StaticOrder, true, true>(lds, g, S, E, tidl);
        } else if (st == 0) {
            rms_rows(xsrc, INP(1) + l * 1024, (bf16_t*)(wsl + O_XN), TC, gwl, NGW, lanel);
        } else if (st == 13) {
            rms_rows(xdst, INP(13) + l * 1024, (bf16_t*)(wsl + O_XN), TC, gwl, NGW, lanel);
        } else if (st == 7) {
            post_mla((bf16_t*)(wsl + O_BQ), (const bf16_t*)(wsl + O_BKN), (const bf16_t*)(wsl + O_KR), (bf16_t*)(wsl + O_BK), INP(9) + l * 96, INP(10) + l * 96, (const f32x2*)(wsl + O_TABM), gwl, NGW, lanel);
        } else if (st == 16) {
            combine_A((const bf16_t*)(wsl + O_OG), (const float*)(wsl + O_LSE), (bf16_t*)(wsl + O_OA), gwl, NGW, lanel);
        } else {
            unsigned* q = (unsigned*)(wsl + O_CTL) + (ch * DEPTH + l) * 8 + rep * 64;
            const int x0 = (int)(__builtin_amdgcn_s_getreg((3 << 11) | 20) & 7u);
            bool fastB;
            {
                const float* gq = INP(9) + l * 96; const float* gk = INP(10) + l * 96;
                float a = fmaxf(fabsf(gq[lanel]), lanel < 32 ? fabsf(gq[64 + lanel]) : 0.f), b = fmaxf(fabsf(gk[lanel]), lanel < 32 ? fabsf(gk[64 + lanel]) : 0.f);
#pragma unroll
                for (int o = 32; o >= 1; o >>= 1) { a = fmaxf(a, __shfl_xor(a, o)); b = fmaxf(b, __shfl_xor(b, o)); }
                fastB = __builtin_amdgcn_readfirstlane(__builtin_bit_cast(int, a * b * (96.f * 0.10206207261596575f * LOG2E))) <= __builtin_bit_cast(int, 100.f);
            }
            for (int qi = 0; qi < 8; ++qi) {
                const int x = (x0 + qi) & 7;
                unsigned nxt = 0u;
                if (tidl == 0) nxt = atomicAdd(q + x, 1u);
                for (;;) {
                    __syncthreads();
                    if (tidl == 0) shq[0] = nxt;
                    __syncthreads();
                    const int idx = (int)shq[0];
                    if (idx >= CB * 56) break;
                    if (tidl == 0) nxt = atomicAdd(q + x, 1u);
#ifdef PROBE_KIND
                    if (rep == 1 && ((idx < CB * 16) ? 0 : (idx < CB * 40 ? 1 : 2)) != PROBE_KIND) continue;
#endif
                    int tidi = tidl; asm volatile("" : "+v"(tidi));
                    const int lanei = tidi & 63;
                    if (idx < CB * 16) { const int bh = x + 8 * (idx >> 4), sq = 15 - (idx & 15);
                        if (fastB) attn_B_blk2<true>((const bf16_t*)(wsl + O_BQ), (const bf16_t*)(wsl + O_BK), (const bf16_t*)(wsl + O_BVT), (bf16_t*)(wsl + O_OA) + 256, bh >> 3, bh & 7, sq, lds, tidi, lanei, wavel);
                        else attn_B_blk((const bf16_t*)(wsl + O_BQ), (const bf16_t*)(wsl + O_BK), (const bf16_t*)(wsl + O_BVT), (bf16_t*)(wsl + O_OA) + 256, bh >> 3, bh & 7, sq, lds, tidi, lanei, wavel, 1.f); }
                    else if (idx < CB * 40) { const int i2 = idx - CB * 16, pr = x + 8 * (i2 >> 4), i16 = i2 & 15, bl = pr / 12, head = pr - bl * 12, g2 = (head >> 2) * 2;
                        attn_A_blk((const bf16_t*)(wsl + O_AQ), (const bf16_t*)(wsl + O_AK), (const bf16_t*)(wsl + O_AVT), (bf16_t*)(wsl + O_OG), (float*)(wsl + O_LSE), bl, head, i16 & ((1 << g2) - 1), i16 >> g2, lds, tidi, lanei, wavel); }
                    else { const int i2 = idx - CB * 40, bh = x + 8 * (i2 >> 4), sq = 15 - (i2 & 15);
                        attn_C_blk((const bf16_t*)(wsl + O_CQ), (const bf16_t*)(wsl + O_CK), (const bf16_t*)(wsl + O_CVT), (bf16_t*)(wsl + O_OA) + 768, bh >> 3, bh & 7, sq, lds, tidi, lanei, wavel); }
                }
            }
        }
        if (sync) xcd_barrier(xbar);
    }
}

extern "C" void kernel_launch(void* const* d_in, const int* in_sizes, int n_in, void* d_out, int out_size, void* d_ws, size_t ws_size, hipStream_t stream) {
    static int grid = 0;
    if (grid == 0) {
        if (n_in != 16 || ws_size < WS_END) { fprintf(stderr, "kernel_launch: need 16 inputs and %zu bytes of workspace; got %d, %zu\n", (size_t)WS_END, n_in, ws_size); grid = -1; return; }
        int dev = 0, cus = 0, per_cu = 0;
        hipGetDevice(&dev); hipDeviceGetAttribute(&cus, hipDeviceAttributeMultiprocessorCount, dev);
        if (hipFuncSetAttribute((const void*)mega_fwd, hipFuncAttributeMaxDynamicSharedMemorySize, LDS_BYTES) != hipSuccess) { fprintf(stderr, "kernel_launch: hipFuncSetAttribute failed\n"); grid = -1; return; }
        if (hipOccupancyMaxActiveBlocksPerMultiprocessor(&per_cu, (const void*)mega_fwd, 512, LDS_BYTES) != hipSuccess || per_cu < 1) { fprintf(stderr, "kernel_launch: occupancy query says %d blocks per CU\n", per_cu); per_cu = 1; }
        (void)hipGetLastError();
        grid = cus > 0 ? cus : 256;
    }
    if (grid < 0) return;
    Args a{};
    for (int i = 0; i < 16; ++i) a.in[i] = (const float*)d_in[i];
    a.out = (float*)d_out; a.ws = (unsigned char*)d_ws;
    for (int i = 0; i < 8; ++i) a.invfA[i] = (float)pow(500000.0, -(double)i / 8.0);
    for (int i = 0; i < 16; ++i) a.invfM[i] = (float)pow(500000.0, -(double)i / 16.0);
    void* args[] = {&a};
    hipError_t e = hipLaunchCooperativeKernel((const void*)mega_fwd, dim3(grid), dim3(512), args, LDS_BYTES, stream);
    if (e != hipSuccess) fprintf(stderr, "kernel_launch: cooperative launch failed: %s (grid %d)\n", hipGetErrorString(e), grid);
}
```

```cpp
#include <hip/hip_runtime.h>
#include <hip/hip_cooperative_groups.h>
#include <cstdio>
#include <cstdint>
#include <cmath>
namespace cg = cooperative_groups;
namespace pg8 {
#define PG8_LAS __attribute__((address_space(3)))
typedef unsigned short bf16_t;
typedef short bf16x8 __attribute__((ext_vector_type(8)));
typedef float f32x4 __attribute__((ext_vector_type(4)));
typedef unsigned u32x4 __attribute__((ext_vector_type(4)));
constexpr int BM = 256, BK = 64, HALF = 128, HTB = HALF * BK * 2  , STAGE_BYTES = 8 * HTB, NXCD = 8, WGM = 8;

__host__ __device__ __forceinline__ int lds_byte(int r, int c) { const int st = (r >> 4) * 2 + (c >> 5), rr = r & 15, cc = c & 31, ob = rr * 64 + cc * 2; return st * 1024 + (ob ^ (((ob >> 9) & 1) << 5)); }
__host__ __device__ __forceinline__ void stage_rc(int b, int& R, int& C) { const int st = b / 1024, sb = b % 1024, swz = sb ^ (((sb >> 9) & 1) << 5); R = (st >> 1) * 16 + swz / 64; C = (st & 1) * 32 + (swz % 64) / 2; }
__host__ __device__ __forceinline__ int perm32(int rho) { const int n = rho >> 4, i = rho & 15; return 8 * (i >> 2) + 4 * n + (i & 3); }

struct Unit { int pm, pn; };
struct Gemm { const bf16_t* A; const bf16_t* Bt; int M, N, K; int dil = 0; };

struct StaticOrder {
    int nM, nN, nwg, G, c;
    __host__ __device__ void init(int M, int N, int G_, int c_) { nM = M / BM; nN = N / BM; nwg = nM * nN; G = G_; c = c_; }
    __host__ __device__ bool next(int i, Unit& u) const {
        const long L = (long)i * G + c; if (L >= nwg) return false;
        int wgid = (int)L; { const int q = nwg / NXCD, r = nwg % NXCD, xcd = wgid % NXCD, off = wgid / NXCD; wgid = (xcd < r ? xcd * (q + 1) : r * (q + 1) + (xcd - r) * q) + off; }
        const int nig = WGM * nN, gid = wgid / nig, fm = gid * WGM, gsz = (nM - fm) < WGM ? (nM - fm) : WGM;
        u.pm = fm + ((wgid % nig) % gsz); u.pn = (wgid % nig) / gsz; return true;
    }
    __device__ __forceinline__ void a_ready(const Unit&) const {}
    __device__ __forceinline__ void done(const Unit&) const {}
};
__device__ __forceinline__ unsigned cvt_pk_bf16(float lo, float hi) { unsigned r; asm volatile("v_cvt_pk_bf16_f32 %0, %1, %2" : "=v"(r) : "v"(lo), "v"(hi)); return r; }
__device__ __forceinline__ const char* b_unit(const Gemm& g, const Unit& u, size_t tstep, int& bs) {
    bs = 1;
    if (g.dil != 0 && (u.pm == 1 || u.pm == 2)) {
        const int sh = (u.pm == 1) ? 2 : 4; bs = 1 << sh;
        const int j0 = u.pn * 256, b = j0 >> 12, jj = j0 & 4095, rc = jj >> (12 - sh), u0 = jj & ((4096 >> sh) - 1);
        return (const char*)g.Bt + (size_t)((b << 12) + (u0 << sh) + rc) * g.K * 2;
    }
    return (const char*)g.Bt + (size_t)u.pn * tstep;
}
template <class Epi, class Sched, bool ALIGN_EPI = false, bool SP2 = false>
__device__ __forceinline__ void gemm_phase(PG8_LAS unsigned char* lds, const Gemm g, const Sched& S, const Epi& E, const int tid_in) {
    const int tid = tid_in, wid = __builtin_amdgcn_readfirstlane(tid >> 6), lane = tid & 63, wr = wid >> 2, wc = wid & 3, fr = lane & 15, fq = lane >> 4;
    const int K = g.K, nt = K / BK;
    unsigned voffA[2], voffBr[2], voffBc[2];
#pragma unroll
    for (int i = 0; i < 2; ++i) { int R, C; stage_rc(tid * 16 + i * 8192, R, C); const int Rb = (Epi::PERM || E.perm_b()) ? ((R & ~31) + perm32(R & 31)) : R;
        voffA[i] = (unsigned)(R * K + C) * 2u; voffBr[i] = (unsigned)(Rb * K) * 2u; voffBc[i] = (unsigned)C * 2u; }
    const size_t kstep = (size_t)(BK * 2);
    const size_t hstep = (size_t)HALF * K * 2;
    const size_t tstep = 2 * hstep;
    const unsigned ldsw = (unsigned)wid * 1024u;
    const int aoff = lds_byte(wr * 64 + fr, fq * 8), boff = lds_byte(wc * 32 + fr, fq * 8);
#define PG8_SA(b, h) (((b) * 2 + (h)) * HTB)
#define PG8_SB(b, h) ((4 + (b) * 2 + (h)) * HTB)
#define PG8_STAGE(bufoff, gbase, voff) do { _Pragma("unroll") for (int _i = 0; _i < 2; ++_i) \
        __builtin_amdgcn_global_load_lds((const unsigned*)((const char*)(gbase) + (voff)[_i]), (PG8_LAS unsigned*)(lds + (bufoff) + ldsw + _i * 8192), 16, 0, 0); } while (0)
#define PG8_LDA(dst, b, h) do { _Pragma("unroll") for (int m = 0; m < 4; ++m) _Pragma("unroll") for (int k = 0; k < 2; ++k) dst[m][k] = *(const PG8_LAS bf16x8*)(lds + PG8_SA(b, h) + aoff + m * 2048 + k * 1024); } while (0)
#define PG8_LDB(dst, b, h) do { _Pragma("unroll") for (int n = 0; n < 2; ++n) _Pragma("unroll") for (int k = 0; k < 2; ++k) dst[n][k] = *(const PG8_LAS bf16x8*)(lds + PG8_SB(b, h) + boff + n * 2048 + k * 1024); } while (0)
#define PG8_MMA(ai, bj, At, Bt) do { __builtin_amdgcn_s_setprio(1); _Pragma("unroll") for (int m = 0; m < 4; ++m) _Pragma("unroll") for (int n = 0; n < 2; ++n) _Pragma("unroll") for (int k = 0; k < 2; ++k) \
        acc[ai][bj][m][n] = __builtin_amdgcn_mfma_f32_16x16x32_bf16(Bt[n][k], At[m][k], acc[ai][bj][m][n], 0, 0, 0); __builtin_amdgcn_s_setprio(0); } while (0)
#define PG8_WAIT_V(n) asm volatile("s_waitcnt vmcnt(" #n ")" ::: "memory")
#define PG8_WAIT_L(n) asm volatile("s_waitcnt lgkmcnt(" #n ")" ::: "memory")
#define PG8_BAR __builtin_amdgcn_s_barrier()
#define PG8_SCHED __builtin_amdgcn_sched_barrier(0)
    Unit cur, nxt; int ui = 0;
    if (!S.next(0, cur)) return;
    f32x4 acc[2][2][4][2];
#pragma unroll
    for (int a = 0; a < 2; ++a)
#pragma unroll
        for (int b = 0; b < 2; ++b)
#pragma unroll
            for (int m = 0; m < 4; ++m)
#pragma unroll
                for (int n = 0; n < 2; ++n) acc[a][b][m][n] = (f32x4){0.f, 0.f, 0.f, 0.f};
    bf16x8 At[4][2], B0[2][2], B1[2][2];
    const char* cA = (const char*)g.A + (size_t)cur.pm * tstep; int bsc; const char* cB = b_unit(g, cur, tstep, bsc);
    size_t hBc = hstep * (size_t)bsc;
    S.a_ready(cur);
    { const unsigned vBc[2] = {voffBr[0] * (unsigned)bsc + voffBc[0], voffBr[1] * (unsigned)bsc + voffBc[1]};
    if constexpr (SP2) {
        PG8_STAGE(PG8_SB(0, 0), cB, vBc); PG8_STAGE(PG8_SB(0, 1), cB + hBc, vBc); PG8_STAGE(PG8_SA(0, 0), cA, voffA); PG8_STAGE(PG8_SA(0, 1), cA + hstep, voffA);
        if (wr == 1) PG8_BAR;
        PG8_WAIT_V(2); PG8_BAR;
        PG8_STAGE(PG8_SB(1, 0), cB + kstep, vBc); PG8_STAGE(PG8_SA(1, 0), cA + kstep, voffA); PG8_STAGE(PG8_SB(1, 1), cB + hBc + kstep, vBc);
        PG8_WAIT_V(6); PG8_BAR;
    } else {
        PG8_STAGE(PG8_SB(0, 0), cB, vBc); PG8_STAGE(PG8_SA(0, 0), cA, voffA); PG8_STAGE(PG8_SB(0, 1), cB + hBc, vBc); PG8_STAGE(PG8_SA(0, 1), cA + hstep, voffA);
        if (wr == 1) PG8_BAR;
        PG8_WAIT_V(4); PG8_BAR;
        PG8_STAGE(PG8_SB(1, 0), cB + kstep, vBc); PG8_STAGE(PG8_SA(1, 0), cA + kstep, voffA); PG8_STAGE(PG8_SB(1, 1), cB + hBc + kstep, vBc);
        PG8_WAIT_V(6); PG8_BAR;
    }
    }
    for (;;) {
        const bool has_next = S.next(ui + 1, nxt);
        const char* nA = has_next ? (const char*)g.A + (size_t)nxt.pm * tstep : cA; int bsn = bsc; const char* nB = cB; if (has_next) nB = b_unit(g, nxt, tstep, bsn);
        const size_t hBn = hstep * (size_t)bsn;
        for (int t = 0; t < nt; t += 2) {
            if constexpr (Epi::HAS_MID) { if (E.mid_at(t)) { if (wr == 0) PG8_BAR; E.mid(acc, cur, wr, wc, fr, fq, t); if (wr == 1) PG8_BAR; } }
            const bool last = (t == nt - 2);
            const char* a1 = cA + (size_t)(t + 1) * kstep;
            const char* a2 = last ? nA : cA + (size_t)(t + 2) * kstep; const char* b2 = last ? nB : cB + (size_t)(t + 2) * kstep;
            const char* a3 = a2 + kstep; const char* b3 = b2 + kstep;
            const unsigned bsel = (unsigned)(last ? bsn : bsc); const unsigned vB[2] = {voffBr[0] * bsel + voffBc[0], voffBr[1] * bsel + voffBc[1]}; const size_t hB = last ? hBn : hBc;
            if (last && has_next) S.a_ready(nxt);
            if constexpr (SP2) {
            PG8_LDB(B0, 0, 0); PG8_LDB(B1, 0, 1); PG8_SCHED; PG8_LDA(At, 0, 0); PG8_STAGE(PG8_SA(1, 1), a1 + hstep, voffA);
            PG8_WAIT_V(8); PG8_WAIT_L(0); PG8_BAR; PG8_MMA(0, 0, At, B0); PG8_MMA(0, 1, At, B1); PG8_BAR; PG8_SCHED;
            PG8_LDA(At, 0, 1); PG8_STAGE(PG8_SB(0, 0), b2, vB); PG8_STAGE(PG8_SB(0, 1), b2 + hB, vB); PG8_STAGE(PG8_SA(0, 0), a2, voffA);
            PG8_WAIT_V(8); PG8_WAIT_L(0); PG8_BAR; PG8_MMA(1, 0, At, B0); PG8_MMA(1, 1, At, B1); PG8_BAR; PG8_SCHED;
            PG8_LDB(B0, 1, 0); PG8_LDB(B1, 1, 1); PG8_SCHED; PG8_LDA(At, 1, 0); PG8_STAGE(PG8_SA(0, 1), a2 + hstep, voffA);
            PG8_WAIT_V(8); PG8_WAIT_L(0); PG8_BAR; PG8_MMA(0, 0, At, B0); PG8_MMA(0, 1, At, B1); PG8_BAR; PG8_SCHED;
            PG8_LDA(At, 1, 1); PG8_STAGE(PG8_SB(1, 0), b3, vB); PG8_STAGE(PG8_SB(1, 1), b3 + hB, vB); PG8_STAGE(PG8_SA(1, 0), a3, voffA);
            PG8_WAIT_V(8); PG8_WAIT_L(0); PG8_BAR; PG8_MMA(1, 0, At, B0); PG8_MMA(1, 1, At, B1); PG8_BAR; PG8_SCHED;
            } else {
            PG8_LDB(B0, 0, 0); PG8_SCHED; PG8_LDA(At, 0, 0); PG8_STAGE(PG8_SA(1, 1), a1 + hstep, voffA);
            PG8_WAIT_L(8); PG8_BAR; PG8_WAIT_L(0); PG8_MMA(0, 0, At, B0); PG8_BAR; PG8_SCHED;
            PG8_LDB(B1, 0, 1); PG8_STAGE(PG8_SB(0, 0), b2, vB);
            PG8_BAR; PG8_WAIT_L(0); PG8_MMA(0, 1, At, B1); PG8_BAR;
            PG8_LDA(At, 0, 1); PG8_STAGE(PG8_SA(0, 0), a2, voffA);
            PG8_BAR; PG8_WAIT_L(0); PG8_MMA(1, 0, At, B0); PG8_BAR; PG8_SCHED;
            PG8_STAGE(PG8_SB(0, 1), b2 + hB, vB);
            PG8_WAIT_V(6); PG8_BAR; PG8_MMA(1, 1, At, B1); PG8_BAR;
            PG8_LDB(B0, 1, 0); PG8_SCHED; PG8_LDA(At, 1, 0); PG8_STAGE(PG8_SA(0, 1), a2 + hstep, voffA);
            PG8_WAIT_L(8); PG8_BAR; PG8_WAIT_L(0); PG8_MMA(0, 0, At, B0); PG8_BAR; PG8_SCHED;
            PG8_LDB(B1, 1, 1); PG8_STAGE(PG8_SB(1, 0), b3, vB);
            PG8_BAR; PG8_WAIT_L(0); PG8_MMA(0, 1, At, B1); PG8_BAR;
            PG8_LDA(At, 1, 1); PG8_STAGE(PG8_SA(1, 0), a3, voffA);
            PG8_BAR; PG8_WAIT_L(0); PG8_MMA(1, 0, At, B0); PG8_BAR; PG8_SCHED;
            PG8_STAGE(PG8_SB(1, 1), b3 + hB, vB);
            PG8_WAIT_V(6); PG8_BAR; PG8_MMA(1, 1, At, B1); PG8_BAR;
            }
        }
        if constexpr (ALIGN_EPI) { if (wr == 0) PG8_BAR; }
        if constexpr (!Epi::AFTER_DRAIN) { E(acc, cur, wr, wc, fr, fq); S.done(cur); }
        if (!has_next) break;
#pragma unroll
        for (int a = 0; a < 2; ++a)
#pragma unroll
            for (int b = 0; b < 2; ++b)
#pragma unroll
                for (int m = 0; m < 4; ++m)
#pragma unroll
                    for (int n = 0; n < 2; ++n) acc[a][b][m][n] = (f32x4){0.f, 0.f, 0.f, 0.f};
        cur = nxt; cA = nA; cB = nB; bsc = bsn; hBc = hBn; ++ui;
        if constexpr (ALIGN_EPI) { if (wr == 1) PG8_BAR; }
    }
    PG8_WAIT_V(0);
    if constexpr (!ALIGN_EPI) { if (wr == 0) PG8_BAR; }
    PG8_BAR;
    if constexpr (Epi::AFTER_DRAIN) { E.fused(acc, cur, wr, wc, fr, fq, lds, wid, lane); S.done(cur); }
#undef PG8_SA
#undef PG8_SB
#undef PG8_STAGE
#undef PG8_LDA
#undef PG8_LDB
#undef PG8_MMA
#undef PG8_WAIT_V
#undef PG8_WAIT_L
#undef PG8_BAR
#undef PG8_SCHED
}
}

using pg8::f32x4;
using pg8::bf16_t;
typedef short s16x8 __attribute__((ext_vector_type(8)));
typedef short s16x4 __attribute__((ext_vector_type(4)));
typedef float f32x16 __attribute__((ext_vector_type(16)));
typedef unsigned u32x2 __attribute__((ext_vector_type(2)));
typedef unsigned u32x4v __attribute__((ext_vector_type(4)));
#define LAS __attribute__((address_space(3)))

constexpr int BATCH = 16, SEQ = 4096, DM = 1024, DEPTH = 4, DFF = 4096, INC = 7328;
constexpr int NCHUNK = 2, CB = BATCH / NCHUNK, TC = CB * SEQ;
constexpr float EPS = 1e-6f;
constexpr int NWIN = 7424;
constexpr int NPROJ = 6144, NSWV = 1280;

constexpr size_t al256(size_t x) { return (x + 255) & ~(size_t)255; }
constexpr size_t O_CTL = 0;
constexpr size_t O_BAR = 4096;
constexpr size_t O_TABA = 4096 + 16384;
constexpr size_t O_TABM = O_TABA + (size_t)SEQ * 8 * 8;
constexpr size_t O_WIN = O_TABM + (size_t)SEQ * 16 * 8;
constexpr size_t S_WIN = (size_t)NWIN * 1024 * 2;
constexpr size_t O_WQB = O_WIN + DEPTH * S_WIN;
constexpr size_t S_WQB = (size_t)768 * 256 * 2;
constexpr size_t O_WKVB = O_WQB + DEPTH * S_WQB;
constexpr size_t S_WKVB = (size_t)1024 * 128 * 2;
constexpr size_t O_WBRA = O_WKVB + DEPTH * S_WKVB;
constexpr size_t S_WBRA = (size_t)1024 * 256 * 2;
constexpr size_t O_WBRB = O_WBRA + DEPTH * S_WBRA;
constexpr size_t S_WBRB = (size_t)1024 * 512 * 2;
constexpr size_t S_WBR = (size_t)1024 * 1280 * 2;
constexpr size_t O_WBRC = O_WBRB + DEPTH * S_WBRB;
constexpr size_t O_WOUT = O_WBRC + DEPTH * S_WBRB;
constexpr size_t S_WOUT = (size_t)1024 * 1024 * 2;
constexpr size_t O_W1 = O_WOUT + DEPTH * S_WOUT;
constexpr size_t S_W1 = (size_t)4096 * 1024 * 2;
constexpr size_t O_W2 = O_W1 + DEPTH * S_W1;
constexpr size_t O_ACT = al256(O_W2 + DEPTH * S_W1);
constexpr size_t O_XN = O_ACT;
constexpr size_t O_AQ = O_XN + (size_t)TC * 1024 * 2;
constexpr size_t O_AK = O_AQ + (size_t)TC * 768 * 2;
constexpr size_t O_AVT = O_AK + (size_t)TC * 768 * 2;
constexpr size_t O_BQL = O_AVT + (size_t)TC * 768 * 2;
constexpr size_t O_BKV = O_BQL + (size_t)TC * 256 * 2;
constexpr size_t O_KVAN = O_BKV + (size_t)TC * 256 * 2;
constexpr size_t O_CQ = O_KVAN + (size_t)TC * 128 * 2;
constexpr size_t O_CK = O_CQ + (size_t)TC * 512 * 2;
constexpr size_t O_CVT = O_CK + (size_t)TC * 512 * 2;
constexpr size_t O_GATE = O_CVT + (size_t)TC * 512 * 2;
constexpr size_t O_BQ = O_GATE + (size_t)TC * 3072 * 2;
constexpr size_t O_BKN = O_BQ + (size_t)TC * 768 * 2;
constexpr size_t O_BK = O_BKN + (size_t)TC * 512 * 2;
constexpr size_t O_BVT = O_BK + (size_t)TC * 768 * 2;
constexpr size_t O_OA = O_BVT + (size_t)TC * 512 * 2;
constexpr size_t O_OB = O_OA + (size_t)TC * 256 * 2;
constexpr size_t O_OC = O_OB + (size_t)TC * 512 * 2;
constexpr size_t O_OG = O_OC + (size_t)TC * 512 * 2;
constexpr size_t O_LSE = O_OG + (size_t)TC * 768 * 2;
constexpr size_t O_KR = O_LSE + (size_t)TC * 12 * 4;
constexpr size_t O_SSQ = O_KR + (size_t)TC * 32 * 2;
constexpr size_t WS_END = O_SSQ + (size_t)TC * 2 * 4 * 4;
constexpr size_t O_MF = O_AQ;
constexpr size_t O_U = O_AQ;
static_assert((size_t)TC * 1024 * 4 <= O_BQL - O_AQ, "MF overlay");
static_assert(O_U + (size_t)TC * 4096 * 2 <= WS_END, "U overlay");

constexpr int LDS_BYTES = 131072 + 1024;

struct Args {
    const float* in[16];
    float* out; unsigned char* ws;
    float invfA[8]; float invfM[16];
};

__device__ __forceinline__ unsigned cvtpk(float lo, float hi) { unsigned r; asm volatile("v_cvt_pk_bf16_f32 %0, %1, %2" : "=v"(r) : "v"(lo), "v"(hi)); return r; }
__device__ __forceinline__ u32x4v pack8(const f32x4 a, const f32x4 b) { u32x4v w; w.x = cvtpk(a[0], a[1]); w.y = cvtpk(a[2], a[3]); w.z = cvtpk(b[0], b[1]); w.w = cvtpk(b[2], b[3]); return w; }
__device__ __forceinline__ float bf2f(unsigned short h) { return __builtin_bit_cast(float, (unsigned)h << 16); }
__device__ __forceinline__ unsigned short f2bf1(float f) { return (unsigned short)(cvtpk(f, 0.f) & 0xffffu); }
template <int CTRL> __device__ __forceinline__ float dpp_f(float x) { return __builtin_bit_cast(float, __builtin_amdgcn_update_dpp(0, __builtin_bit_cast(int, x), CTRL, 0xf, 0xf, true)); }
__device__ __forceinline__ float row_sum16(float x) {
    x += dpp_f<0xB1>(x);
    x += dpp_f<0x4E>(x);
    x += dpp_f<0x141>(x);
    x += dpp_f<0x140>(x);
    return x;
}
__device__ __forceinline__ float lane_x32(float x, int hi) {
    const unsigned b = __builtin_bit_cast(unsigned, x);
    const auto r = __builtin_amdgcn_permlane32_swap(b, b, false, false);
    return __builtin_bit_cast(float, hi ? (unsigned)r[0] : (unsigned)r[1]);
}
__device__ __forceinline__ float lane_x16(float x, int oddrow) {
    const unsigned b = __builtin_bit_cast(unsigned, x);
    const auto r = __builtin_amdgcn_permlane16_swap(b, b, false, false);
    return __builtin_bit_cast(float, oddrow ? (unsigned)r[0] : (unsigned)r[1]);
}
__device__ __forceinline__ float wave_sum(float v) { const int l_ = (int)__lane_id(); v = row_sum16(v); v += lane_x16(v, (l_ >> 4) & 1); v += lane_x32(v, l_ >> 5); return v; }
__device__ __forceinline__ float fexp2(float x) { return __builtin_amdgcn_exp2f(x); }
__device__ __forceinline__ float flog2(float x) { return __builtin_amdgcn_logf(x); }
constexpr float LOG2E = 1.4426950408889634f, LN2 = 0.6931471805599453f;

struct EpiProj {
    static constexpr bool PERM = false, AFTER_DRAIN = false;
    unsigned char* ws; const float* gaq; const float* gak;
    __device__ __forceinline__ void operator()(const f32x4 (&acc)[2][2][4][2], const pg8::Unit& u, int wr, int wc, int fr, int fq) const {
        const int pn = u.pn;
        const int row0 = u.pm * 256 + wr * 64 + fr;
        if (pn < 6) {
            const bool isk = pn >= 3; const int head = 4 * (isk ? pn - 3 : pn) + wc;
            bf16_t* base = (bf16_t*)(ws + (isk ? O_AK : O_AQ)) + head * 64 + 8 * fq;
            const float* gp = (isk ? gak : gaq) + 8 * fq;
            f32x4 gv[2][2];
#pragma unroll
            for (int bj = 0; bj < 2; ++bj)
#pragma unroll
                for (int n = 0; n < 2; ++n) gv[bj][n] = *(const f32x4*)(gp + 32 * bj + 4 * n);
            const float* tab = (const float*)(ws + O_TABA);
            f32x4 nt[4];
            { const float* tp0 = tab + (size_t)(row0 & (SEQ - 1)) * 16;
#pragma unroll
              for (int q = 0; q < 4; ++q) nt[q] = *(const f32x4*)(tp0 + 4 * q); }
#pragma unroll
            for (int ai = 0; ai < 2; ++ai)
#pragma unroll
                for (int m = 0; m < 4; ++m) {
                    const int row = row0 + ai * 128 + m * 16;
                    const f32x4 t0 = nt[0], t1 = nt[1], t2 = nt[2], t3 = nt[3];
                    if (ai * 4 + m + 1 < 8) {
                        const int rown = row0 + ((ai * 4 + m + 1) >> 2) * 128 + ((ai * 4 + m + 1) & 3) * 16; const float* tpn = tab + (size_t)(rown & (SEQ - 1)) * 16;
#pragma unroll
                        for (int q = 0; q < 4; ++q) nt[q] = *(const f32x4*)(tpn + 4 * q); }
                    float ss = 0.f;
#pragma unroll
                    for (int bj = 0; bj < 2; ++bj)
#pragma unroll
                        for (int n = 0; n < 2; ++n) { const f32x4 v = acc[ai][bj][m][n]; ss += (v[0] * v[0] + v[1] * v[1]) + (v[2] * v[2] + v[3] * v[3]); }
                    ss += lane_x16(ss, fq & 1); ss += lane_x32(ss, fq >> 1);
                    const float rs = __builtin_amdgcn_rsqf(ss * (1.f / 64.f) + EPS);
                    f32x4 y[2][2];
#pragma unroll
                    for (int bj = 0; bj < 2; ++bj)
#pragma unroll
                        for (int n = 0; n < 2; ++n) y[bj][n] = acc[ai][bj][m][n] * rs * gv[bj][n];
                    const float cs[8] = {t0[0], t0[2], t1[0], t1[2], t2[0], t2[2], t3[0], t3[2]}, sn[8] = {t0[1], t0[3], t1[1], t1[3], t2[1], t2[3], t3[1], t3[3]};
                    f32x4 yr[2];
#pragma unroll
                    for (int n = 0; n < 2; ++n)
#pragma unroll
                        for (int e = 0; e < 4; ++e) { const float pr = lane_x16(y[0][n][e], fq & 1); const float v = y[0][n][e], c_ = cs[4 * n + e], s_ = sn[4 * n + e];
                            yr[n][e] = (fq == 0) ? (v * c_ - pr * s_) : ((fq == 1) ? (v * c_ + pr * s_) : v); }
                    y[0][0] = yr[0]; y[0][1] = yr[1];
                    bf16_t* rowp = base + (size_t)row * 768;
#pragma unroll
                    for (int bj = 0; bj < 2; ++bj) *(u32x4v*)(rowp + 32 * bj) = pack8(y[bj][0], y[bj][1]);
                }
            return;
        }
        if (pn == 6 || pn == 7) {
            float* ssq = (float*)(ws + O_SSQ) + (pn == 7 ? (size_t)TC * 4 : 0);
#pragma unroll
            for (int ai = 0; ai < 2; ++ai)
#pragma unroll
                for (int m = 0; m < 4; ++m) {
                    const int row = row0 + ai * 128 + m * 16;
                    float ss = 0.f;
#pragma unroll
                    for (int bj = 0; bj < 2; ++bj) {
                        const f32x4 v0 = acc[ai][bj][m][0], v1 = acc[ai][bj][m][1];
                        const u32x4v w = pack8(v0, v1);
                        const float sq = ((v0[0] * v0[0] + v0[1] * v0[1]) + (v0[2] * v0[2] + v0[3] * v0[3])) + ((v1[0] * v1[0] + v1[1] * v1[1]) + (v1[2] * v1[2] + v1[3] * v1[3]));
                        const int cl = wc * 32 + 8 * fq;
                        if (pn == 6) { *(u32x4v*)((bf16_t*)(ws + O_BQL) + (size_t)row * 256 + bj * 128 + cl) = w; ss += sq; }
                        else if (bj == 0) { *(u32x4v*)((bf16_t*)(ws + O_KVAN) + (size_t)row * 128 + cl) = w; ss += sq; }
                        else if (wc == 0) { *(u32x4v*)((bf16_t*)(ws + O_KR) + (size_t)row * 32 + cl) = w; }
                    }
                    ss += lane_x16(ss, fq & 1); ss += lane_x32(ss, fq >> 1);
                    if (fq == 0) ssq[(size_t)row * 4 + wc] = ss;
                }
            return;
        }
        if (pn >= 12) {
            unsigned char* gb = (unsigned char*)(ws + O_GATE) + (size_t)row0 * 3072 + (pn - 12) * 256 + wc * 32 + 8 * fq;
#pragma unroll
            for (int ai = 0; ai < 2; ++ai)
#pragma unroll
                for (int m = 0; m < 4; ++m) {
                    unsigned char* rowp = gb + (size_t)(ai * 128 + m * 16) * 3072;
#pragma unroll
                    for (int bj = 0; bj < 2; ++bj) {
                        u32x2 w;
#pragma unroll
                        for (int n = 0; n < 2; ++n) { const f32x4 v = acc[ai][bj][m][n]; unsigned q[4];
#pragma unroll
                            for (int e = 0; e < 4; ++e) q[e] = (unsigned)(__builtin_amdgcn_rcpf(1.f + fexp2(-v[e] * LOG2E)) * 255.f + 0.5f);
                            const unsigned pk = q[0] | (q[1] << 8) | (q[2] << 16) | (q[3] << 24); if (n == 0) w.x = pk; else w.y = pk; }
                        *(u32x2*)(rowp + bj * 128) = w;
                    }
                }
            return;
        }
        bf16_t* base; int c0;
        if (pn < 10) { base = (bf16_t*)(ws + O_CQ); c0 = (pn - 8) * 256; }
        else { base = (bf16_t*)(ws + O_CK); c0 = (pn - 10) * 256; }
        const int col0 = c0 + wc * 32 + 8 * fq;
#pragma unroll
        for (int ai = 0; ai < 2; ++ai)
#pragma unroll
            for (int m = 0; m < 4; ++m) {
                bf16_t* rowp = base + (size_t)(row0 + ai * 128 + m * 16) * 512 + col0;
#pragma unroll
                for (int bj = 0; bj < 2; ++bj) *(u32x4v*)(rowp + bj * 128) = pack8(acc[ai][bj][m][0], acc[ai][bj][m][1]);
            }
    }
};
struct EpiSwapV {
    static constexpr bool PERM = false, AFTER_DRAIN = false;
    bf16_t *AVt, *CVt;
    __device__ __forceinline__ void operator()(const f32x4 (&acc)[2][2][4][2], const pg8::Unit& u, int wr, int wc, int fr, int fq) const {
        const int pm = u.pm;
        const int row0 = (pm < 3 ? pm * 256 : (pm - 3) * 256) + wr * 64 + fr, col0 = u.pn * 256 + wc * 32 + 4 * fq;
        bf16_t* base = pm < 3 ? AVt : CVt;
#pragma unroll
        for (int ai = 0; ai < 2; ++ai)
#pragma unroll
            for (int m = 0; m < 4; ++m) {
                bf16_t* rowp = base + (size_t)(row0 + ai * 128 + m * 16) * TC + col0;
#pragma unroll
                for (int bj = 0; bj < 2; ++bj)
#pragma unroll
                    for (int n = 0; n < 2; ++n) {
                        const f32x4 v = acc[ai][bj][m][n];
                        u32x2 w; w.x = cvtpk(v[0], v[1]); w.y = cvtpk(v[2], v[3]);
                        *(u32x2*)(rowp + bj * 128 + n * 16) = w;
                    }
            }
    }
};
template <int ACT  , int SCL  > struct EpiBf {
    static constexpr bool PERM = false, AFTER_DRAIN = false;
    bf16_t* O; int ldc; const float* ssq; float invn;
    __device__ __forceinline__ void operator()(const f32x4 (&acc)[2][2][4][2], const pg8::Unit& u, int wr, int wc, int fr, int fq) const {
        const int row0 = u.pm * 256 + wr * 64 + fr, col0 = u.pn * 256 + wc * 32 + 4 * fq;
        f32x4 cscl[2][2];
        if (SCL == 2) {
#pragma unroll
            for (int bj = 0; bj < 2; ++bj)
#pragma unroll
                for (int n = 0; n < 2; ++n) {
#pragma unroll
                    for (int e = 0; e < 4; ++e) { const f32x4 q = *(const f32x4*)(ssq + (size_t)(col0 + bj * 128 + n * 16 + e) * 4); cscl[bj][n][e] = __builtin_amdgcn_rsqf(((q[0] + q[1]) + (q[2] + q[3])) * invn + EPS); } }
        }
        float rsc[8];
        if (SCL == 1) {
#pragma unroll
            for (int g = 0; g < 8; ++g) { const f32x4 q = *(const f32x4*)(ssq + (size_t)(row0 + (g >> 2) * 128 + (g & 3) * 16) * 4); rsc[g] = __builtin_amdgcn_rsqf(((q[0] + q[1]) + (q[2] + q[3])) * invn + EPS); }
        }
#pragma unroll
        for (int ai = 0; ai < 2; ++ai)
#pragma unroll
            for (int m = 0; m < 4; ++m) {
                const int row = row0 + ai * 128 + m * 16;
                bf16_t* rowp = O + (size_t)row * ldc + col0;
                float rscl = 1.f;
                if (SCL == 1) rscl = rsc[ai * 4 + m];
#pragma unroll
                for (int bj = 0; bj < 2; ++bj)
#pragma unroll
                    for (int n = 0; n < 2; ++n) {
                        f32x4 v = acc[ai][bj][m][n];
                        if (SCL == 1) v = v * rscl;
                        if (SCL == 2) v = v * cscl[bj][n];
                        if (ACT == 1) {
#pragma unroll
                            for (int e = 0; e < 4; ++e) { const float r = fmaxf(v[e], 0.f); v[e] = r * r; }
                        }
                        u32x2 w; w.x = cvtpk(v[0], v[1]); w.y = cvtpk(v[2], v[3]);
                        *(u32x2*)(rowp + bj * 128 + n * 16) = w;
                    }
            }
    }
};
struct EpiGcat {
    const unsigned char* GATE; bf16_t* MG;
    static __device__ __forceinline__ f32x4 g4u(const unsigned w) { f32x4 r;
        r[0] = fmaxf((float)(w & 0xffu) * (1.f / 255.f), 1e-18f); r[1] = fmaxf((float)((w >> 8) & 0xffu) * (1.f / 255.f), 1e-18f);
        r[2] = fmaxf((float)((w >> 16) & 0xffu) * (1.f / 255.f), 1e-18f); r[3] = fmaxf((float)(w >> 24) * (1.f / 255.f), 1e-18f); return r; }
    __device__ __forceinline__ void mid(f32x4 (&acc)[2][2][4][2], const pg8::Unit& u, int wr, int wc, int fr, int fq, int seg) const {
        asm volatile("" : "+v"(fr), "+v"(fq));
        const int row0 = u.pm * 256 + wr * 64 + fr, col0 = u.pn * 256 + wc * 32 + 4 * fq;
        const unsigned char* gbase = GATE + (size_t)row0 * 3072 + seg * 1024 + col0;
        unsigned cn[4], cd[4], nn[4], nd[4];
#pragma unroll
        for (int q = 0; q < 4; ++q) { cn[q] = *(const unsigned*)(gbase + (q >> 1) * 128 + (q & 1) * 16); cd[q] = *(const unsigned*)(gbase + 1024 + (q >> 1) * 128 + (q & 1) * 16); }
#pragma unroll
        for (int g = 0; g < 8; ++g) {
            const int ai = g >> 2, m = g & 3;
            if (g + 1 < 8) { const unsigned char* gp = gbase + (size_t)(((g + 1) >> 2) * 128 + ((g + 1) & 3) * 16) * 3072;
#pragma unroll
                for (int q = 0; q < 4; ++q) { nn[q] = *(const unsigned*)(gp + (q >> 1) * 128 + (q & 1) * 16); nd[q] = *(const unsigned*)(gp + 1024 + (q >> 1) * 128 + (q & 1) * 16); } }
#pragma unroll
            for (int q = 0; q < 4; ++q) { const f32x4 num = g4u(cn[q]), den = g4u(cd[q]);
#pragma unroll
                for (int e = 0; e < 4; ++e) acc[ai][q >> 1][m][q & 1][e] *= num[e] * __builtin_amdgcn_rcpf(den[e]); }
            asm volatile("" ::: "memory");
#pragma unroll
            for (int q = 0; q < 4; ++q) { cn[q] = nn[q]; cd[q] = nd[q]; }
        }
    }
    __device__ __forceinline__ void operator()(const f32x4 (&acc)[2][2][4][2], const pg8::Unit& u, int wr, int wc, int fr, int fq) const {
        const int row0 = u.pm * 256 + wr * 64 + fr, col0 = u.pn * 256 + wc * 32 + 4 * fq;
        const unsigned char* gbase = GATE + (size_t)row0 * 3072 + 2048 + col0;
        unsigned cg[4], ng[4];
#pragma unroll
        for (int q = 0; q < 4; ++q) cg[q] = *(const unsigned*)(gbase + (q >> 1) * 128 + (q & 1) * 16);
#pragma unroll
        for (int g = 0; g < 8; ++g) {
            const int ai = g >> 2, m = g & 3;
            if (g + 1 < 8) { const unsigned char* gp = gbase + (size_t)(((g + 1) >> 2) * 128 + ((g + 1) & 3) * 16) * 3072;
#pragma unroll
                for (int q = 0; q < 4; ++q) ng[q] = *(const unsigned*)(gp + (q >> 1) * 128 + (q & 1) * 16); }
            bf16_t* op = MG + (size_t)(row0 + ai * 128 + m * 16) * 1024 + col0;
#pragma unroll
            for (int q = 0; q < 4; ++q) { const f32x4 v = acc[ai][q >> 1][m][q & 1] * g4u(cg[q]);
                u32x2 w; w.x = cvtpk(v[0], v[1]); w.y = cvtpk(v[2], v[3]); *(u32x2*)(op + (q >> 1) * 128 + (q & 1) * 16) = w; }
            asm volatile("" ::: "memory");
#pragma unroll
            for (int q = 0; q < 4; ++q) cg[q] = ng[q];
        }
    }
};
struct EpiResid {
    static constexpr bool PERM = false, AFTER_DRAIN = false;
    const float* base; float* out;
    __device__ __forceinline__ void operator()(const f32x4 (&acc)[2][2][4][2], const pg8::Unit& u, int wr, int wc, int fr, int fq) const {
        const int row0 = u.pm * 256 + wr * 64 + fr, col0 = u.pn * 256 + wc * 32 + 4 * fq;
        const size_t off0 = (size_t)row0 * 1024 + col0;
        f32x4 cb[4], nb[4];
#pragma unroll
        for (int q = 0; q < 4; ++q) cb[q] = *(const f32x4*)(base + off0 + (q >> 1) * 128 + (q & 1) * 16);
#pragma unroll
        for (int g = 0; g < 8; ++g) {
            const int ai = g >> 2, m = g & 3;
            if (g + 1 < 8) { const size_t offn = off0 + (size_t)(((g + 1) >> 2) * 128 + ((g + 1) & 3) * 16) * 1024;
#pragma unroll
                for (int q = 0; q < 4; ++q) nb[q] = *(const f32x4*)(base + offn + (q >> 1) * 128 + (q & 1) * 16); }
            const size_t off = off0 + (size_t)(ai * 128 + m * 16) * 1024;
#pragma unroll
            for (int q = 0; q < 4; ++q) *(f32x4*)(out + off + (q >> 1) * 128 + (q & 1) * 16) = cb[q] + acc[ai][q >> 1][m][q & 1];
            asm volatile("" ::: "memory");
#pragma unroll
            for (int q = 0; q < 4; ++q) cb[q] = nb[q];
        }
    }
};

struct EpiSwapVP {
    bf16_t *AVt, *CVt;
    __device__ __forceinline__ void operator()(const f32x4 (&acc)[2][2][4][2], const pg8::Unit& u, int wr, int wc, int fr, int fq) const {
        const int pm = u.pm;
        const int row0 = (pm < 3 ? pm * 256 : (pm - 3) * 256) + wr * 64 + fr, col0 = u.pn * 256 + wc * 32 + 8 * fq;
        bf16_t* base = (pm < 3 ? AVt : CVt) + (size_t)row0 * TC + col0;
#pragma unroll
        for (int ai = 0; ai < 2; ++ai)
#pragma unroll
            for (int m = 0; m < 4; ++m)
#pragma unroll
                for (int bj = 0; bj < 2; ++bj) *(u32x4v*)(base + (size_t)(ai * 128 + m * 16) * TC + bj * 128) = pack8(acc[ai][bj][m][0], acc[ai][bj][m][1]);
    }
};
template <int SCL  > struct EpiBfP {
    bf16_t* O; int ldc; const float* ssq; float invn;
    __device__ __forceinline__ void operator()(const f32x4 (&acc)[2][2][4][2], const pg8::Unit& u, int wr, int wc, int fr, int fq) const {
        const int row0 = u.pm * 256 + wr * 64 + fr, col0 = u.pn * 256 + wc * 32 + 8 * fq;
        float rsc[8]; f32x4 csc[2][2];
        if (SCL == 1) {
#pragma unroll
            for (int g = 0; g < 8; ++g) { const f32x4 q = *(const f32x4*)(ssq + (size_t)(row0 + (g >> 2) * 128 + (g & 3) * 16) * 4); rsc[g] = __builtin_amdgcn_rsqf(((q[0] + q[1]) + (q[2] + q[3])) * invn + EPS); }
        } else {
#pragma unroll
            for (int bj = 0; bj < 2; ++bj)
#pragma unroll
                for (int e = 0; e < 8; ++e) { const f32x4 q = *(const f32x4*)(ssq + (size_t)(col0 + bj * 128 + e) * 4); csc[bj][e >> 2][e & 3] = __builtin_amdgcn_rsqf(((q[0] + q[1]) + (q[2] + q[3])) * invn + EPS); }
        }
#pragma unroll
        for (int ai = 0; ai < 2; ++ai)
#pragma unroll
            for (int m = 0; m < 4; ++m)
#pragma unroll
                for (int bj = 0; bj < 2; ++bj) {
                    f32x4 v0 = acc[ai][bj][m][0], v1 = acc[ai][bj][m][1];
                    if (SCL == 1) { v0 = v0 * rsc[ai * 4 + m]; v1 = v1 * rsc[ai * 4 + m]; } else { v0 = v0 * csc[bj][0]; v1 = v1 * csc[bj][1]; }
                    *(u32x4v*)(O + (size_t)(row0 + ai * 128 + m * 16) * ldc + col0 + bj * 128) = pack8(v0, v1);
                }
    }
};
struct EpiGcatP {
    const unsigned char* GATE; bf16_t* MG;
    static __device__ __forceinline__ void g8(const u32x2 w, f32x4& a, f32x4& b) { a = EpiGcat::g4u(w.x); b = EpiGcat::g4u(w.y); }
    __device__ __forceinline__ void mid(f32x4 (&acc)[2][2][4][2], const pg8::Unit& u, int wr, int wc, int fr, int fq, int seg) const {
        asm volatile("" : "+v"(fr), "+v"(fq));
        const int row0 = u.pm * 256 + wr * 64 + fr, col0 = u.pn * 256 + wc * 32 + 8 * fq;
        const unsigned char* gbase = GATE + (size_t)row0 * 3072 + seg * 1024 + col0;
        u32x2 cn[2], cd[2], nn[2], nd[2];
#pragma unroll
        for (int bj = 0; bj < 2; ++bj) { cn[bj] = *(const u32x2*)(gbase + bj * 128); cd[bj] = *(const u32x2*)(gbase + 1024 + bj * 128); }
#pragma unroll
        for (int g = 0; g < 8; ++g) {
            const int ai = g >> 2, m = g & 3;
            if (g + 1 < 8) { const unsigned char* gp = gbase + (size_t)(((g + 1) >> 2) * 128 + ((g + 1) & 3) * 16) * 3072;
#pragma unroll
                for (int bj = 0; bj < 2; ++bj) { nn[bj] = *(const u32x2*)(gp + bj * 128); nd[bj] = *(const u32x2*)(gp + 1024 + bj * 128); } }
#pragma unroll
            for (int bj = 0; bj < 2; ++bj) { f32x4 n0, n1, d0, d1; g8(cn[bj], n0, n1); g8(cd[bj], d0, d1);
#pragma unroll
                for (int e = 0; e < 4; ++e) { acc[ai][bj][m][0][e] *= n0[e] * __builtin_amdgcn_rcpf(d0[e]); acc[ai][bj][m][1][e] *= n1[e] * __builtin_amdgcn_rcpf(d1[e]); } }
            asm volatile("" ::: "memory");
#pragma unroll
            for (int bj = 0; bj < 2; ++bj) { cn[bj] = nn[bj]; cd[bj] = nd[bj]; }
        }
    }
    __device__ __forceinline__ void operator()(const f32x4 (&acc)[2][2][4][2], const pg8::Unit& u, int wr, int wc, int fr, int fq) const {
        const int row0 = u.pm * 256 + wr * 64 + fr, col0 = u.pn * 256 + wc * 32 + 8 * fq;
        const unsigned char* gbase = GATE + (size_t)row0 * 3072 + 2048 + col0;
        u32x2 cg[2], ng[2];
#pragma unroll
        for (int bj = 0; bj < 2; ++bj) cg[bj] = *(const u32x2*)(gbase + bj * 128);
#pragma unroll
        for (int g = 0; g < 8; ++g) {
            const int ai = g >> 2, m = g & 3;
            if (g + 1 < 8) { const unsigned char* gp = gbase + (size_t)(((g + 1) >> 2) * 128 + ((g + 1) & 3) * 16) * 3072;
#pragma unroll
                for (int bj = 0; bj < 2; ++bj) ng[bj] = *(const u32x2*)(gp + bj * 128); }
            bf16_t* op = MG + (size_t)(row0 + ai * 128 + m * 16) * 1024 + col0;
#pragma unroll
            for (int bj = 0; bj < 2; ++bj) { f32x4 g0, g1; g8(cg[bj], g0, g1); *(u32x4v*)(op + bj * 128) = pack8(acc[ai][bj][m][0] * g0, acc[ai][bj][m][1] * g1); }
            asm volatile("" ::: "memory");
#pragma unroll
            for (int bj = 0; bj < 2; ++bj) cg[bj] = ng[bj];
        }
    }
};
enum { M_PROJ = 0, M_SWAPV, M_BQ, M_BKN, M_BVT, M_U, M_GCAT, M_RES };
struct EpiDyn {
    static constexpr bool PERM = false, AFTER_DRAIN = false;
    unsigned char* ws; int mode; const float* rbase; float* rout; const float* g0; const float* g1;
    static constexpr bool HAS_MID = true;
    __device__ __forceinline__ bool perm_b() const { return mode != M_RES; }
    __device__ __forceinline__ bool mid_at(int t) const { return mode == M_GCAT && (t == 4 || t == 12); }
    __device__ __forceinline__ void mid(f32x4 (&acc)[2][2][4][2], const pg8::Unit& u, int wr, int wc, int fr, int fq, int t) const {
        EpiGcatP E{(const unsigned char*)(ws + O_GATE), (bf16_t*)(ws + O_XN)}; E.mid(acc, u, wr, wc, fr, fq, t == 4 ? 0 : 1); }
    __device__ __forceinline__ void operator()(const f32x4 (&acc)[2][2][4][2], const pg8::Unit& u, int wr, int wc, int fr, int fq) const {
        asm volatile("" : "+v"(fr), "+v"(fq));
        switch (mode) {
        case M_PROJ: { EpiProj E{ws, g0, g1}; E(acc, u, wr, wc, fr, fq); } break;
        case M_SWAPV: { EpiSwapVP E{(bf16_t*)(ws + O_AVT), (bf16_t*)(ws + O_CVT)}; E(acc, u, wr, wc, fr, fq); } break;
        case M_BQ: { EpiBfP<1> E{(bf16_t*)(ws + O_BQ), 768, (const float*)(ws + O_SSQ), 1.f / 256.f}; E(acc, u, wr, wc, fr, fq); } break;
        case M_BKN: { EpiBfP<1> E{(bf16_t*)(ws + O_BKN), 512, (const float*)(ws + O_SSQ) + (size_t)TC * 4, 1.f / 128.f}; E(acc, u, wr, wc, fr, fq); } break;
        case M_BVT: { EpiBfP<2> E{(bf16_t*)(ws + O_BVT), TC, (const float*)(ws + O_SSQ) + (size_t)TC * 4, 1.f / 128.f}; E(acc, u, wr, wc, fr, fq); } break;
        case M_U: {
            bf16_t* ob = (bf16_t*)(ws + O_U) + (size_t)(u.pm * 256 + wr * 64 + fr) * 4096 + u.pn * 256 + wc * 32 + 8 * fq;
#pragma unroll
            for (int ai = 0; ai < 2; ++ai)
#pragma unroll
                for (int m = 0; m < 4; ++m)
#pragma unroll
                    for (int bj = 0; bj < 2; ++bj) {
                        f32x4 v0 = acc[ai][bj][m][0], v1 = acc[ai][bj][m][1];
#pragma unroll
                        for (int e = 0; e < 4; ++e) { const float a = fmaxf(v0[e], 0.f), b = fmaxf(v1[e], 0.f); v0[e] = a * a; v1[e] = b * b; }
                        u32x4v w; w.x = cvtpk(v0[0], v0[1]); w.y = cvtpk(v0[2], v0[3]); w.z = cvtpk(v1[0], v1[1]); w.w = cvtpk(v1[2], v1[3]);
                        *(u32x4v*)(ob + (size_t)(ai * 128 + m * 16) * 4096 + bj * 128) = w;
                    }
        } break;
        case M_GCAT: { EpiGcatP E{(const unsigned char*)(ws + O_GATE), (bf16_t*)(ws + O_XN)}; E(acc, u, wr, wc, fr, fq); } break;
        default: { EpiResid E{rbase, rout}; E(acc, u, wr, wc, fr, fq); } break;
        }
    }
};

__device__ __forceinline__ void tr_seg(const float* W, int ldn, int K, int col0, int ncols, bf16_t* WT, int dstrow0, LAS float* scr, int gw, int NGW, int lane, unsigned& ibase, const float* kg = nullptr, int ldk = 0, int kofs = 0) {
    if (ldk == 0) ldk = K;
    const int nblk = ncols / 32, items = (K / 64) * nblk;
    int it = (int)(((unsigned)gw + (unsigned)NGW - ibase % (unsigned)NGW) % (unsigned)NGW);
    for (; it < items; it += NGW) {
        const int kb = it / nblk, nb = it % nblk, k0 = 64 * kb, n0 = 32 * nb;
#pragma unroll
        for (int i = 0; i < 32; ++i) { const int kk = 2 * i + (lane >> 5); scr[kk * 33 + (lane & 31)] = W[(size_t)(k0 + kk) * ldn + col0 + n0 + (lane & 31)] * (kg ? kg[k0 + kk] : 1.f); }
        asm volatile("s_waitcnt lgkmcnt(0)" ::: "memory");
        const int c = lane & 7;
#pragma unroll
        for (int j = 0; j < 4; ++j) { const int n = (lane >> 3) + 8 * j; const LAS float* s = scr + (8 * c) * 33 + n;
            u32x4v o; o.x = cvtpk(s[0 * 33], s[1 * 33]); o.y = cvtpk(s[2 * 33], s[3 * 33]); o.z = cvtpk(s[4 * 33], s[5 * 33]); o.w = cvtpk(s[6 * 33], s[7 * 33]);
            *(u32x4v*)(WT + (size_t)(dstrow0 + n0 + n) * ldk + kofs + k0 + 8 * c) = o; }
        asm volatile("s_waitcnt lgkmcnt(0)" ::: "memory");
    }
    ibase += (unsigned)items;
}

__device__ __forceinline__ void rms_rows(const float* x, const float* gain, bf16_t* out, int nrows, int gw, int NGW, int lane) {
    f32x4 gv[4];
#pragma unroll
    for (int j = 0; j < 4; ++j) gv[j] = *((const f32x4*)gain + 64 * j + lane);
    f32x4 v[4], nv[4];
    if (gw < nrows) {
#pragma unroll
        for (int j = 0; j < 4; ++j) v[j] = ((const f32x4*)(x + (size_t)gw * 1024) + lane)[64 * j];
    }
    for (int r = gw; r < nrows; r += NGW) {
        if (r + NGW < nrows) {
#pragma unroll
            for (int j = 0; j < 4; ++j) nv[j] = ((const f32x4*)(x + (size_t)(r + NGW) * 1024) + lane)[64 * j];
        }
        float s = 0.f;
#pragma unroll
        for (int j = 0; j < 4; ++j) s += (v[j][0] * v[j][0] + v[j][1] * v[j][1]) + (v[j][2] * v[j][2] + v[j][3] * v[j][3]);
        const float rs = __builtin_amdgcn_rsqf(wave_sum(s) * (1.f / 1024.f) + EPS);
        u32x2* o = (u32x2*)(out + (size_t)r * 1024) + lane;
#pragma unroll
        for (int j = 0; j < 4; ++j) { u32x2 w; w.x = cvtpk(v[j][0] * rs * gv[j][0], v[j][1] * rs * gv[j][1]); w.y = cvtpk(v[j][2] * rs * gv[j][2], v[j][3] * rs * gv[j][3]); o[64 * j] = w; }
#pragma unroll
        for (int j = 0; j < 4; ++j) v[j] = nv[j];
    }
}
typedef float f32x2 __attribute__((ext_vector_type(2)));
__device__ __forceinline__ void post_proj(bf16_t* AQ, bf16_t* AK, bf16_t* BQL, const bf16_t* BKV, bf16_t* KVAN, const float* gaq, const float* gak, const float* gqa, const float* gkva,
                                          const f32x2* tabA, int gw, int NGW, int lane) {
    const float g_q = gaq[lane], g_k = gak[lane];
    f32x4 g4 = *((const f32x4*)gqa + lane); f32x2 g2 = *((const f32x2*)gkva + lane);
    for (int t = gw; t < TC; t += NGW) {
        const int s = t & (SEQ - 1);
        const f32x2 cs = tabA[s * 8 + (lane & 7)];
#pragma unroll 4
        for (int hh = 0; hh < 24; ++hh) {
            bf16_t* p = (hh < 12 ? AQ + (size_t)t * 768 + hh * 64 : AK + (size_t)t * 768 + (hh - 12) * 64) + lane;
            const float xv = bf2f(*p);
            const float rs = __builtin_amdgcn_rsqf(wave_sum(xv * xv) * (1.f / 64.f) + EPS);
            float y = xv * rs * (hh < 12 ? g_q : g_k);
            const float pr = __shfl_xor(y, 8);
            if (lane < 8) y = y * cs[0] - pr * cs[1]; else if (lane < 16) y = y * cs[0] + pr * cs[1];
            *p = f2bf1(y);
        }
        { u32x2* p = (u32x2*)(BQL + (size_t)t * 256) + lane; const u32x2 w = *p;
          const float a = __builtin_bit_cast(float, w.x << 16), b = __builtin_bit_cast(float, w.x & 0xffff0000u), c = __builtin_bit_cast(float, w.y << 16), d = __builtin_bit_cast(float, w.y & 0xffff0000u);
          const float rs = __builtin_amdgcn_rsqf(wave_sum((a * a + b * b) + (c * c + d * d)) * (1.f / 256.f) + EPS);
          u32x2 o; o.x = cvtpk(a * rs * g4[0], b * rs * g4[1]); o.y = cvtpk(c * rs * g4[2], d * rs * g4[3]); *p = o; }
        { const unsigned w = *((const unsigned*)(BKV + (size_t)t * 256) + lane);
          const float a = __builtin_bit_cast(float, w << 16), b = __builtin_bit_cast(float, w & 0xffff0000u);
          const float rs = __builtin_amdgcn_rsqf(wave_sum(a * a + b * b) * (1.f / 128.f) + EPS);
          *((unsigned*)(KVAN + (size_t)t * 128) + lane) = cvtpk(a * rs * g2[0], b * rs * g2[1]); }
    }
}
__device__ __forceinline__ float half_sum(float v) { v = row_sum16(v); v += lane_x16(v, (int)(__lane_id() >> 4) & 1); return v; }
__device__ __forceinline__ void post_mla(bf16_t* BQ, const bf16_t* BKN, const bf16_t* KR, bf16_t* BK, const float* gq, const float* gk, const f32x2* tabM, int gw, int NGW, int lane) {
    const int lh = lane >> 5, ll = lane & 31;
    const float gq0 = gq[ll], gq1 = gq[32 + ll], gq2 = gq[64 + ll], gk0 = gk[ll], gk1 = gk[32 + ll], gk2 = gk[64 + ll];
    unsigned short cq[4][3], ck[4][2], ckr, nq[4][3], nk[4][2], nkr;
#define PM_LOAD(t, Q, K_, KRV) do { _Pragma("unroll") for (int hp = 0; hp < 4; ++hp) { const int h = 2 * hp + lh; \
        const bf16_t* p = BQ + (size_t)(t) * 768 + h * 96; Q[hp][0] = p[ll]; Q[hp][1] = p[32 + ll]; Q[hp][2] = p[64 + ll]; \
        const bf16_t* kp = BKN + (size_t)(t) * 512 + h * 64; K_[hp][0] = kp[ll]; K_[hp][1] = kp[32 + ll]; } \
        KRV = KR[(size_t)(t) * 32 + ll]; } while (0)
    if (gw < TC) PM_LOAD(gw, cq, ck, ckr);
    for (int t = gw; t < TC; t += NGW) {
        if (t + NGW < TC) PM_LOAD(t + NGW, nq, nk, nkr);
        const int s = t & (SEQ - 1);
        const f32x2 cs = tabM[s * 16 + (ll & 15)];
        const float kr = bf2f(ckr);
#pragma unroll
        for (int hp = 0; hp < 4; ++hp) {
            const int h = 2 * hp + lh;
            {   bf16_t* p = BQ + (size_t)t * 768 + h * 96;
                const float q0 = bf2f(cq[hp][0]), q1 = bf2f(cq[hp][1]), q2 = bf2f(cq[hp][2]);
                const float rs = __builtin_amdgcn_rsqf(half_sum(q0 * q0 + q1 * q1 + q2 * q2) * (1.f / 96.f) + EPS);
                const float rq = rs * (0.10206207261596575f * LOG2E);
                const float y0 = q0 * rq * gq0, y1 = q1 * rq * gq1; float y2 = q2 * rq * gq2;
                const float pr = lane_x16(y2, (ll >> 4) & 1);
                y2 = (ll < 16) ? (y2 * cs[0] - pr * cs[1]) : (y2 * cs[0] + pr * cs[1]);
                p[ll] = f2bf1(y0); p[32 + ll] = f2bf1(y1); p[64 + ll] = f2bf1(y2); }
            {   const float k0 = bf2f(ck[hp][0]), k1 = bf2f(ck[hp][1]);
                const float rs = __builtin_amdgcn_rsqf(half_sum(k0 * k0 + k1 * k1 + kr * kr) * (1.f / 96.f) + EPS);
                const float y0 = k0 * rs * gk0, y1 = k1 * rs * gk1; float y2 = kr * rs * gk2;
                const float pr = lane_x16(y2, (ll >> 4) & 1);
                y2 = (ll < 16) ? (y2 * cs[0] - pr * cs[1]) : (y2 * cs[0] + pr * cs[1]);
                bf16_t* p = BK + (size_t)t * 768 + h * 96;
                p[ll] = f2bf1(y0); p[32 + ll] = f2bf1(y1); p[64 + ll] = f2bf1(y2); }
        }
#pragma unroll
        for (int hp = 0; hp < 4; ++hp) { cq[hp][0] = nq[hp][0]; cq[hp][1] = nq[hp][1]; cq[hp][2] = nq[hp][2]; ck[hp][0] = nk[hp][0]; ck[hp][1] = nk[hp][1]; }
        ckr = nkr;
    }
#undef PM_LOAD
}

#define MFMA32(a, b, c) __builtin_amdgcn_mfma_f32_32x32x16_bf16((a), (b), (c), 0, 0, 0)
__device__ __forceinline__ s16x8 ld8(const bf16_t* p) { return *(const s16x8*)p; }
__device__ __forceinline__ s16x8 ldv(const bf16_t* p) { const s16x4 a = *(const s16x4*)p, b = *(const s16x4*)(p + 8); return (s16x8){a[0], a[1], a[2], a[3], b[0], b[1], b[2], b[3]}; }
__device__ __forceinline__ s16x8 packp(const float* p) {
    const unsigned a = cvtpk(p[0], p[1]), b = cvtpk(p[2], p[3]), c = cvtpk(p[4], p[5]), d = cvtpk(p[6], p[7]);
    const u32x4v w = {a, b, c, d}; return __builtin_bit_cast(s16x8, w);
}
__device__ __forceinline__ void store_o(bf16_t* orow  , const f32x16& o0, const f32x16& o1, float inv, int hi) {
#pragma unroll
    for (int t = 0; t < 2; ++t)
#pragma unroll
        for (int jp = 0; jp < 4; jp += 2) {
            const f32x16& o = t == 0 ? o0 : o1;
            unsigned ax = cvtpk(o[4 * jp] * inv, o[4 * jp + 1] * inv), ay = cvtpk(o[4 * jp + 2] * inv, o[4 * jp + 3] * inv);
            unsigned bx = cvtpk(o[4 * jp + 4] * inv, o[4 * jp + 5] * inv), by = cvtpk(o[4 * jp + 6] * inv, o[4 * jp + 7] * inv);
            { const auto r = __builtin_amdgcn_permlane32_swap(ax, bx, false, false); ax = r[0]; bx = r[1]; }
            { const auto r = __builtin_amdgcn_permlane32_swap(ay, by, false, false); ay = r[0]; by = r[1]; }
            const u32x4v w = {ax, ay, bx, by};
            *(u32x4v*)(orow + 32 * t + 8 * jp + 8 * hi) = w;
        }
}
__device__ __forceinline__ void attn_B(const bf16_t* BQ, const bf16_t* BK, const bf16_t* BVt, bf16_t* OB, int bl, int h, int qt, int lane) {
    const int c = lane & 31, hi = lane >> 5;
    const size_t tb = (size_t)bl * SEQ;
    const bf16_t* qp = BQ + (tb + qt * 32 + c) * 768 + h * 96 + hi * 8;
    s16x8 qf[6];
#pragma unroll
    for (int kc = 0; kc < 6; ++kc) qf[kc] = ld8(qp + kc * 16);
    f32x16 o0, o1;
#pragma unroll
    for (int i = 0; i < 16; ++i) { o0[i] = 0.f; o1[i] = 0.f; }
    float m = -1e30f, l = 0.f;
    const float sc = 0.10206207261596575f * LOG2E;
    const int qpos = qt * 32 + c;
    const bf16_t* vbase = BVt + (size_t)(h * 64 + c) * TC + tb + 4 * hi;
    for (int kt = 0; kt <= qt; ++kt) {
        const bf16_t* kp = BK + (tb + kt * 32 + c) * 768 + h * 96 + hi * 8;
        f32x16 s;
#pragma unroll
        for (int i = 0; i < 16; ++i) s[i] = 0.f;
#pragma unroll
        for (int kc = 0; kc < 6; ++kc) s = MFMA32(ld8(kp + kc * 16), qf[kc], s);
        const s16x8 v00 = ldv(vbase + kt * 32), v01 = ldv(vbase + kt * 32 + 16), v10 = ldv(vbase + (size_t)32 * TC + kt * 32), v11 = ldv(vbase + (size_t)32 * TC + kt * 32 + 16);
        float p[16]; float mx = -1e30f;
#pragma unroll
        for (int i = 0; i < 16; ++i) { const int key = kt * 32 + 8 * (i >> 2) + 4 * hi + (i & 3); const float sv = (key <= qpos) ? s[i] * sc : -1e30f; p[i] = sv; mx = fmaxf(mx, sv); }
        mx = fmaxf(mx, __shfl_xor(mx, 32));
        const float mn = fmaxf(m, mx), alpha = fexp2(m - mn); m = mn;
        float ps = 0.f;
#pragma unroll
        for (int i = 0; i < 16; ++i) { p[i] = fexp2(p[i] - mn); ps += p[i]; }
        l = l * alpha + ps;
#pragma unroll
        for (int i = 0; i < 16; ++i) { o0[i] *= alpha; o1[i] *= alpha; }
        const s16x8 pf0 = packp(p), pf1 = packp(p + 8);
        o0 = MFMA32(v00, pf0, o0); o0 = MFMA32(v01, pf1, o0);
        o1 = MFMA32(v10, pf0, o1); o1 = MFMA32(v11, pf1, o1);
    }
    l += lane_x32(l, hi);
    store_o(OB + (tb + qpos) * 1280 + h * 64, o0, o1, 1.f / l, hi);
}
constexpr int KB_STR = 208, VB_STR = 136, KB_BYTES = 64 * KB_STR, VB_BYTES = 64 * VB_STR;
__device__ __forceinline__ s16x8 ldv_lds(const LAS unsigned char* p) { const s16x4 a = *(const LAS s16x4*)p, b = *(const LAS s16x4*)(p + 16); return (s16x8){a[0], a[1], a[2], a[3], b[0], b[1], b[2], b[3]}; }
__device__ __forceinline__ void attn_B_blk(const bf16_t* BQ, const bf16_t* BK, const bf16_t* BVt, bf16_t* OB, int bl, int h, int sq, LAS unsigned char* lds, int tid, int lane, int wave, const float sc) {
    const int c = lane & 31, hi = lane >> 5;
    const size_t tb = (size_t)bl * SEQ;
    const int qt = sq * 8 + wave, qpos = qt * 32 + c, nt = 4 * sq + 4, tlast = 4 * sq + (wave >> 1);
    const bf16_t* qp = BQ + (tb + qpos) * 768 + h * 96 + hi * 8;
    s16x8 qf[6];
#pragma unroll
    for (int kc = 0; kc < 6; ++kc) qf[kc] = ld8(qp + kc * 16);
    f32x16 o0, o1;
#pragma unroll
    for (int i = 0; i < 16; ++i) { o0[i] = 0.f; o1[i] = 0.f; }
    float m = -1e30f, l = 0.f;
    const int kr0 = tid / 12, kc0 = tid % 12, kr1 = (512 + tid) / 12, kc1 = (512 + tid) % 12, vr = tid >> 3, vc = tid & 7;
    const bf16_t* kg0 = BK + (tb + kr0) * 768 + h * 96 + kc0 * 8;
    const bf16_t* kg1 = BK + (tb + kr1) * 768 + h * 96 + kc1 * 8;
    const bf16_t* vg = BVt + (size_t)(h * 64 + vr) * TC + tb + vc * 8;
    LAS unsigned char* kl0 = lds + kr0 * KB_STR + kc0 * 16;
    LAS unsigned char* kl1 = lds + kr1 * KB_STR + kc1 * 16;
    LAS unsigned char* vl = lds + 2 * KB_BYTES + vr * VB_STR + vc * 16;
    u32x4v rk0, rk1, rv;
    rk1 = (u32x4v){0u, 0u, 0u, 0u};
#define B_LOAD(t) do { rk0 = *(const u32x4v*)(kg0 + (size_t)(t) * 64 * 768); if (tid < 256) rk1 = *(const u32x4v*)(kg1 + (size_t)(t) * 64 * 768); rv = *(const u32x4v*)(vg + (t) * 64); } while (0)
#define B_WRITE(b) do { *(LAS u32x4v*)(kl0 + (b) * KB_BYTES) = rk0; if (tid < 256) *(LAS u32x4v*)(kl1 + (b) * KB_BYTES) = rk1; \
        *(LAS u32x2*)(vl + (b) * VB_BYTES) = (u32x2){rv.x, rv.y}; *(LAS u32x2*)(vl + (b) * VB_BYTES + 8) = (u32x2){rv.z, rv.w}; } while (0)
    B_LOAD(0);
    B_WRITE(0);
    __syncthreads();
    if (nt > 1) B_LOAD(1);
    for (int t = 0; t < nt; ++t) {
        const int b = t & 1;
        if (t <= tlast) {
#pragma unroll
            for (int j = 0; j < 2; ++j) {
                const int key0 = t * 64 + j * 32;
                if (key0 <= qt * 32) {
                    const LAS unsigned char* kb = lds + b * KB_BYTES + (32 * j + c) * KB_STR + hi * 16;
                    f32x16 s;
#pragma unroll
                    for (int i = 0; i < 16; ++i) s[i] = 0.f;
#pragma unroll
                    for (int kc = 0; kc < 6; ++kc) s = MFMA32(*(const LAS s16x8*)(kb + kc * 32), qf[kc], s);
                    const LAS unsigned char* vb = lds + 2 * KB_BYTES + b * VB_BYTES + c * VB_STR + 64 * j + 8 * hi;
                    const s16x8 v00 = ldv_lds(vb), v01 = ldv_lds(vb + 32), v10 = ldv_lds(vb + 32 * VB_STR), v11 = ldv_lds(vb + 32 * VB_STR + 32);
                    float p[16]; float mx = -1e30f;
#pragma unroll
                    for (int i = 0; i < 16; ++i) { const int key = key0 + 8 * (i >> 2) + 4 * hi + (i & 3); const float sv = (key <= qpos) ? s[i] * sc : -1e30f; p[i] = sv; mx = fmaxf(mx, sv); }
                    mx = fmaxf(mx, __shfl_xor(mx, 32));
                    const float mn = fmaxf(m, mx), alpha = fexp2(m - mn); m = mn;
                    float ps = 0.f;
#pragma unroll
                    for (int i = 0; i < 16; ++i) { p[i] = fexp2(p[i] - mn); ps += p[i]; }
                    l = l * alpha + ps;
#pragma unroll
                    for (int i = 0; i < 16; ++i) { o0[i] *= alpha; o1[i] *= alpha; }
                    const s16x8 pf0 = packp(p), pf1 = packp(p + 8);
                    o0 = MFMA32(v00, pf0, o0); o0 = MFMA32(v01, pf1, o0);
                    o1 = MFMA32(v10, pf0, o1); o1 = MFMA32(v11, pf1, o1);
                }
            }
        }
        if (t + 1 < nt) B_WRITE(b ^ 1);
        __syncthreads();
        if (t + 2 < nt) B_LOAD(t + 2);
    }
#undef B_LOAD
#undef B_WRITE
    l += lane_x32(l, hi);
    store_o(OB + (tb + qpos) * 1280 + h * 64, o0, o1, 1.f / l, hi);
}
__device__ __forceinline__ void attn_C(const bf16_t* CQ, const bf16_t* CK, const bf16_t* CVt, bf16_t* OC, int bl, int h, int qt, int lane) {
    const int c = lane & 31, hi = lane >> 5;
    const size_t tb = (size_t)bl * SEQ;
    const bf16_t* qp = CQ + (tb + qt * 32 + c) * 512 + h * 64 + hi * 8;
    s16x8 qf[4];
#pragma unroll
    for (int kc = 0; kc < 4; ++kc) qf[kc] = ld8(qp + kc * 16);
    f32x16 o0, o1;
#pragma unroll
    for (int i = 0; i < 16; ++i) { o0[i] = 0.f; o1[i] = 0.f; }
    float carry = 0.f;
    const int qpos = qt * 32 + c;
    const bf16_t* vbase = CVt + (size_t)(h * 64 + c) * TC + tb + 4 * hi;
    for (int kt = qt; kt >= 0; --kt) {
        const bf16_t* kp = CK + (tb + kt * 32 + c) * 512 + h * 64 + hi * 8;
        f32x16 s;
#pragma unroll
        for (int i = 0; i < 16; ++i) s[i] = 0.f;
#pragma unroll
        for (int kc = 0; kc < 4; ++kc) s = MFMA32(ld8(kp + kc * 16), qf[kc], s);
        const s16x8 v00 = ldv(vbase + kt * 32), v01 = ldv(vbase + kt * 32 + 16), v10 = ldv(vbase + (size_t)32 * TC + kt * 32), v11 = ldv(vbase + (size_t)32 * TC + kt * 32 + 16);
        float lom[16], lw[16];
#pragma unroll
        for (int i = 0; i < 16; ++i) {
            const int key = kt * 32 + 8 * (i >> 2) + 4 * hi + (i & 3);
            const float z = s[i] * 0.125f;
            const float sp = fmaxf(z, 0.f) + LN2 * flog2(1.f + fexp2(-fabsf(z) * LOG2E));
            const bool valid = key < qpos;
            lom[i] = valid ? -sp : 0.f;
            lw[i] = valid ? (z - sp) : -1e30f;
        }
        float gs[4], pgs[4], suf[16];
#pragma unroll
        for (int j = 0; j < 4; ++j) {
            suf[4 * j + 3] = 0.f; suf[4 * j + 2] = lom[4 * j + 3]; suf[4 * j + 1] = suf[4 * j + 2] + lom[4 * j + 2]; suf[4 * j] = suf[4 * j + 1] + lom[4 * j + 1];
            gs[j] = suf[4 * j] + lom[4 * j];
            pgs[j] = __shfl_xor(gs[j], 32);
        }
        float T[4]; T[3] = 0.f; T[2] = gs[3] + pgs[3]; T[1] = T[2] + gs[2] + pgs[2]; T[0] = T[1] + gs[1] + pgs[1];
        const float total = T[0] + gs[0] + pgs[0];
        float p[16];
#pragma unroll
        for (int i = 0; i < 16; ++i) {
            const int j = i >> 2;
            const float after = carry + T[j] + (hi == 0 ? pgs[j] : 0.f) + suf[i];
            p[i] = fexp2((lw[i] + after) * LOG2E);
        }
        carry += total;
        const s16x8 pf0 = packp(p), pf1 = packp(p + 8);
        o0 = MFMA32(v00, pf0, o0); o0 = MFMA32(v01, pf1, o0);
        o1 = MFMA32(v10, pf0, o1); o1 = MFMA32(v11, pf1, o1);
        if (__builtin_amdgcn_ballot_w64(carry >= -104.f) == 0ull) break;
    }
    store_o(OC + (tb + qpos) * 1280 + h * 64, o0, o1, 1.f, hi);
}
constexpr int KB2_BYTES = 128 * KB_STR, VB2_STR = 264, VB2_BYTES = 64 * VB2_STR;
template <int OFF> __device__ __forceinline__ void kread6(s16x8 (&k)[6], unsigned addr) {
    asm volatile("ds_read_b128 %0, %1 offset:%2" : "=v"(k[0]) : "v"(addr), "i"(OFF));
    asm volatile("ds_read_b128 %0, %1 offset:%2" : "=v"(k[1]) : "v"(addr), "i"(OFF + 32));
    asm volatile("ds_read_b128 %0, %1 offset:%2" : "=v"(k[2]) : "v"(addr), "i"(OFF + 64));
    asm volatile("ds_read_b128 %0, %1 offset:%2" : "=v"(k[3]) : "v"(addr), "i"(OFF + 96));
    asm volatile("ds_read_b128 %0, %1 offset:%2" : "=v"(k[4]) : "v"(addr), "i"(OFF + 128));
    asm volatile("ds_read_b128 %0, %1 offset:%2" : "=v"(k[5]) : "v"(addr), "i"(OFF + 160));
}
__device__ __forceinline__ void kwait6(s16x8 (&k)[6]) { asm volatile("s_waitcnt lgkmcnt(0)" : "+v"(k[0]), "+v"(k[1]), "+v"(k[2]), "+v"(k[3]), "+v"(k[4]), "+v"(k[5])); }
__device__ __forceinline__ f32x16 qk96r(const s16x8 (&k)[6], const s16x8 (&qf)[6]) {
    f32x16 s;
#pragma unroll
    for (int i = 0; i < 16; ++i) s[i] = 0.f;
#pragma unroll
    for (int kc = 0; kc < 6; ++kc) s = MFMA32(k[kc], qf[kc], s);
    return s;
}
template <bool FAST> __device__ __forceinline__ void attn_B_blk2(const bf16_t* BQ, const bf16_t* BK, const bf16_t* BVt, bf16_t* OB, int bl, int h, int sq, LAS unsigned char* lds, int tid, int lane, int wave) {
    const int c = lane & 31, hi = lane >> 5;
    const size_t tb = (size_t)bl * SEQ;
    const int qt = sq * 8 + wave, qpos = qt * 32 + c, nt = 2 * sq + 2, tl = 2 * sq + (wave >> 2), jl = wave & 3;
    const bf16_t* qp = BQ + (tb + qpos) * 768 + h * 96 + hi * 8;
    s16x8 qf[6];
#pragma unroll
    for (int kc = 0; kc < 6; ++kc) qf[kc] = ld8(qp + kc * 16);
    f32x16 o0, o1;
#pragma unroll
    for (int i = 0; i < 16; ++i) { o0[i] = 0.f; o1[i] = 0.f; }
    float m = -1e30f, l = 0.f;
    const bf16_t* kg[3]; LAS unsigned char* kl[3];
#pragma unroll
    for (int i = 0; i < 3; ++i) { const int idx = tid + 512 * i, r = idx / 12, cc = idx - r * 12; kg[i] = BK + (tb + r) * 768 + h * 96 + cc * 8; kl[i] = lds + r * KB_STR + cc * 16; }
    const bf16_t* vg[2]; LAS unsigned char* vl[2];
#pragma unroll
    for (int i = 0; i < 2; ++i) { const int idx = tid + 512 * i, r = idx >> 4, cc = idx & 15; vg[i] = BVt + (size_t)(h * 64 + r) * TC + tb + cc * 8; vl[i] = lds + 2 * KB2_BYTES + r * VB2_STR + cc * 16; }
    u32x4v rk[3], rv[2];
#define B2_LOAD(t) do { _Pragma("unroll") for (int i_ = 0; i_ < 3; ++i_) rk[i_] = *(const u32x4v*)(kg[i_] + (size_t)(t) * 128 * 768); \
        _Pragma("unroll") for (int i_ = 0; i_ < 2; ++i_) rv[i_] = *(const u32x4v*)(vg[i_] + (t) * 128); } while (0)
#define B2_WRITE(b) do { _Pragma("unroll") for (int i_ = 0; i_ < 3; ++i_) *(LAS u32x4v*)(kl[i_] + (b) * KB2_BYTES) = rk[i_]; \
        _Pragma("unroll") for (int i_ = 0; i_ < 2; ++i_) { *(LAS u32x2*)(vl[i_] + (b) * VB2_BYTES) = (u32x2){rv[i_].x, rv[i_].y}; *(LAS u32x2*)(vl[i_] + (b) * VB2_BYTES + 8) = (u32x2){rv[i_].z, rv[i_].w}; } } while (0)
#define B2_SUB(J, KCUR, KNXT) if ((J) < nsub) { \
        f32x16 sn; \
        if ((J) + 1 < nsub) { kwait6(KNXT); sn = qk96r(KNXT, qf); } \
        if ((J) + 2 < nsub) kread6<((J) + 2) * 32 * KB_STR>(KCUR, kaddr); \
        const LAS unsigned char* vb = vb0 + 64 * (J); \
        const s16x8 v00 = ldv_lds(vb), v01 = ldv_lds(vb + 32), v10 = ldv_lds(vb + 32 * VB2_STR), v11 = ldv_lds(vb + 32 * VB2_STR + 32); \
        float p[16]; \
        if (FAST) { \
            if (t == tl && (J) == jl) { const int key0 = t * 128 + (J) * 32; \
                _Pragma("unroll") for (int i = 0; i < 16; ++i) { const int key = key0 + 8 * (i >> 2) + 4 * hi + (i & 3); p[i] = (key <= qpos) ? fexp2(s[i]) : 0.f; } \
            } else { _Pragma("unroll") for (int i = 0; i < 16; ++i) p[i] = fexp2(s[i]); } \
            float ps0 = 0.f, ps1 = 0.f; \
            _Pragma("unroll") for (int i = 0; i < 8; ++i) { ps0 += p[i]; ps1 += p[8 + i]; } \
            l += ps0 + ps1; \
        } else { \
            float mx = -1e30f; \
            if (t == tl && (J) == jl) { const int key0 = t * 128 + (J) * 32; \
                _Pragma("unroll") for (int i = 0; i < 16; ++i) { const int key = key0 + 8 * (i >> 2) + 4 * hi + (i & 3); const float sv = (key <= qpos) ? s[i] : -1e30f; p[i] = sv; mx = fmaxf(mx, sv); } \
            } else { _Pragma("unroll") for (int i = 0; i < 16; ++i) { p[i] = s[i]; mx = fmaxf(mx, s[i]); } } \
            mx = fmaxf(mx, __shfl_xor(mx, 32)); \
            const float mn = fmaxf(m, mx), alpha = fexp2(m - mn); \
            const bool moved = __builtin_amdgcn_ballot_w64(mn > m) != 0ull; \
            m = mn; \
            float ps = 0.f; \
            _Pragma("unroll") for (int i = 0; i < 16; ++i) { p[i] = fexp2(p[i] - mn); ps += p[i]; } \
            l = l * alpha + ps; \
            if (moved) { _Pragma("unroll") for (int i = 0; i < 16; ++i) { o0[i] *= alpha; o1[i] *= alpha; } } \
        } \
        const s16x8 pf0 = packp(p), pf1 = packp(p + 8); \
        o0 = MFMA32(v00, pf0, o0); o0 = MFMA32(v01, pf1, o0); \
        o1 = MFMA32(v10, pf0, o1); o1 = MFMA32(v11, pf1, o1); \
        if ((J) + 1 < nsub) s = sn; }
    B2_LOAD(0);
    B2_WRITE(0);
    __syncthreads();
    if (nt > 1) B2_LOAD(1);
    for (int t = 0; t < nt; ++t) {
        const int b = t & 1;
        const int nsub = t < tl ? 4 : (t == tl ? jl + 1 : 0);
        if (nsub > 0) {
            const unsigned kaddr = (unsigned)(unsigned long)(lds + b * KB2_BYTES + c * KB_STR + hi * 16);
            const LAS unsigned char* vb0 = lds + 2 * KB2_BYTES + b * VB2_BYTES + c * VB2_STR + 8 * hi;
            s16x8 ka[6], kb_[6];
            kread6<0>(ka, kaddr);
            kwait6(ka);
            f32x16 s = qk96r(ka, qf);
            if (nsub > 1) kread6<32 * KB_STR>(kb_, kaddr);
            B2_SUB(0, ka, kb_)
            B2_SUB(1, kb_, ka)
            B2_SUB(2, ka, kb_)
            B2_SUB(3, kb_, ka)
        }
        if (t + 1 < nt) B2_WRITE(b ^ 1);
        __syncthreads();
        if (t + 2 < nt) B2_LOAD(t + 2);
    }
#undef B2_SUB
#undef B2_LOAD
#undef B2_WRITE
    l += lane_x32(l, hi);
    store_o(OB + (tb + qpos) * 1280 + h * 64, o0, o1, 1.f / l, hi);
}
constexpr int KC_STR = 144, KC_BYTES = 64 * KC_STR;
__device__ __forceinline__ void attn_C_blk(const bf16_t* CQ, const bf16_t* CK, const bf16_t* CVt, bf16_t* OC, int bl, int h, int sq, LAS unsigned char* lds, int tid, int lane, int wave) {
    const int c = lane & 31, hi = lane >> 5;
    const size_t tb = (size_t)bl * SEQ;
    const int qt = sq * 8 + wave, qpos = qt * 32 + c, nt = 4 * sq + 4, tlast = 4 * sq + (wave >> 1);
    const bf16_t* qp = CQ + (tb + qpos) * 512 + h * 64 + hi * 8;
    s16x8 qf[4];
#pragma unroll
    for (int kc = 0; kc < 4; ++kc) qf[kc] = ld8(qp + kc * 16);
    f32x16 o0, o1;
#pragma unroll
    for (int i = 0; i < 16; ++i) { o0[i] = 0.f; o1[i] = 0.f; }
    float carry = 0.f; bool done = false;
    const int kr = tid >> 3, kc8 = tid & 7;
    const bf16_t* kg = CK + (tb + kr) * 512 + h * 64 + kc8 * 8;
    const bf16_t* vg = CVt + (size_t)(h * 64 + kr) * TC + tb + kc8 * 8;
    LAS unsigned char* kl = lds + kr * KC_STR + kc8 * 16;
    LAS unsigned char* vl = lds + 2 * KC_BYTES + kr * VB_STR + kc8 * 16;
    volatile LAS unsigned* fl = (volatile LAS unsigned*)(lds + 2 * KC_BYTES + 2 * VB_BYTES);
    if (tid < 3) fl[tid] = 0u;
    u32x4v rk, rv;
#define C_LOAD(t) do { rk = *(const u32x4v*)(kg + (size_t)(t) * 64 * 512); rv = *(const u32x4v*)(vg + (t) * 64); } while (0)
#define C_WRITE(b) do { *(LAS u32x4v*)(kl + (b) * KC_BYTES) = rk; *(LAS u32x2*)(vl + (b) * VB_BYTES) = (u32x2){rv.x, rv.y}; *(LAS u32x2*)(vl + (b) * VB_BYTES + 8) = (u32x2){rv.z, rv.w}; } while (0)
    C_LOAD(nt - 1);
    C_WRITE(0);
    __syncthreads();
    if (nt > 1) C_LOAD(nt - 2);
    for (int it = 0; it < nt; ++it) {
        const int t = nt - 1 - it, b = it & 1;
        if (!done && t <= tlast) {
#pragma unroll
            for (int jj = 0; jj < 2; ++jj) {
                const int j = 1 - jj, key0 = t * 64 + j * 32;
                if (key0 <= qt * 32 && !done) {
                    const LAS unsigned char* kb = lds + b * KC_BYTES + (32 * j + c) * KC_STR + hi * 16;
                    f32x16 s;
#pragma unroll
                    for (int i = 0; i < 16; ++i) s[i] = 0.f;
#pragma unroll
                    for (int kc = 0; kc < 4; ++kc) s = MFMA32(*(const LAS s16x8*)(kb + kc * 32), qf[kc], s);
                    const LAS unsigned char* vb = lds + 2 * KC_BYTES + b * VB_BYTES + c * VB_STR + 64 * j + 8 * hi;
                    const s16x8 v00 = ldv_lds(vb), v01 = ldv_lds(vb + 32), v10 = ldv_lds(vb + 32 * VB_STR), v11 = ldv_lds(vb + 32 * VB_STR + 32);
                    float lom[16], lw[16];
#pragma unroll
                    for (int i = 0; i < 16; ++i) {
                        const int key = key0 + 8 * (i >> 2) + 4 * hi + (i & 3);
                        const float z = s[i] * 0.125f;
                        const float sp = fmaxf(z, 0.f) + LN2 * flog2(1.f + fexp2(-fabsf(z) * LOG2E));
                        const bool valid = key < qpos;
                        lom[i] = valid ? -sp : 0.f;
                        lw[i] = valid ? (z - sp) : -1e30f;
                    }
                    float gs[4], pgs[4], suf[16];
#pragma unroll
                    for (int jg = 0; jg < 4; ++jg) {
                        suf[4 * jg + 3] = 0.f; suf[4 * jg + 2] = lom[4 * jg + 3]; suf[4 * jg + 1] = suf[4 * jg + 2] + lom[4 * jg + 2]; suf[4 * jg] = suf[4 * jg + 1] + lom[4 * jg + 1];
                        gs[jg] = suf[4 * jg] + lom[4 * jg];
                        pgs[jg] = lane_x32(gs[jg], hi);
                    }
                    float T[4]; T[3] = 0.f; T[2] = gs[3] + pgs[3]; T[1] = T[2] + gs[2] + pgs[2]; T[0] = T[1] + gs[1] + pgs[1];
                    const float total = T[0] + gs[0] + pgs[0];
                    float p[16];
#pragma unroll
                    for (int i = 0; i < 16; ++i) {
                        const int jg = i >> 2;
                        const float after = carry + T[jg] + (hi == 0 ? pgs[jg] : 0.f) + suf[i];
                        p[i] = fexp2((lw[i] + after) * LOG2E);
                    }
                    carry += total;
                    const s16x8 pf0 = packp(p), pf1 = packp(p + 8);
                    o0 = MFMA32(v00, pf0, o0); o0 = MFMA32(v01, pf1, o0);
                    o1 = MFMA32(v10, pf0, o1); o1 = MFMA32(v11, pf1, o1);
                    done = (__builtin_amdgcn_ballot_w64(carry >= -104.f) == 0ull);
                }
            }
        }
        if (it + 1 < nt) C_WRITE(b ^ 1);
        if (!done && lane == 0) fl[it % 3] = 1u;
        if (tid == 0) fl[(it + 1) % 3] = 0u;
        __syncthreads();
        if (fl[it % 3] == 0u) break;
        if (it + 2 < nt) C_LOAD(t - 2);
    }
#undef C_LOAD
#undef C_WRITE
    store_o(OC + (tb + qpos) * 1280 + h * 64, o0, o1, 1.f, hi);
}
constexpr int VA_STR = 776, KA_BYTES = 384 * KC_STR;
template <bool FAST> __device__ __forceinline__ void attn_A_blk(const bf16_t* AQ, const bf16_t* AK, const bf16_t* AVt, bf16_t* OG, float* LSE, int bl, int head, int rc, int chunk, LAS unsigned char* lds, int tid, int lane, int wave) {
    const int c = lane & 31, hi = lane >> 5, g2 = (head >> 2) * 2, L = SEQ >> g2;
    const size_t tb = (size_t)bl * SEQ;
    const int u0 = chunk * 256, kbase = u0 - 128;
    {   u32x4v rk[6], rv[6];
#pragma unroll
        for (int i = 0; i < 6; ++i) {
            const int idx = tid + 512 * i, row = idx >> 3, cc = idx & 7; int uk = kbase + row; uk = uk < 0 ? 0 : uk;
            rk[i] = *(const u32x4v*)(AK + (tb + ((size_t)uk << g2) + rc) * 768 + head * 64 + cc * 8);
            const int vrow = idx / 48, vcc = idx - vrow * 48; int uv = kbase + 8 * vcc; uv = uv < 0 ? 0 : uv;
            rv[i] = *(const u32x4v*)(AVt + (size_t)(head * 64 + vrow) * TC + tb + (size_t)rc * L + uv);
        }
#pragma unroll
        for (int i = 0; i < 6; ++i) {
            const int idx = tid + 512 * i, row = idx >> 3, cc = idx & 7;
            *(LAS u32x4v*)(lds + row * KC_STR + cc * 16) = rk[i];
            const int vrow = idx / 48, vcc = idx - vrow * 48;
            LAS unsigned char* vp = lds + KA_BYTES + vrow * VA_STR + vcc * 16;
            *(LAS u32x2*)vp = (u32x2){rv[i].x, rv[i].y}; *(LAS u32x2*)(vp + 8) = (u32x2){rv[i].z, rv[i].w};
        }
    }
    const int uq = u0 + 32 * wave + c;
    const size_t tq = ((size_t)uq << g2) + rc;
    const bf16_t* qp = AQ + (tb + tq) * 768 + head * 64 + hi * 8;
    s16x8 qf[4];
#pragma unroll
    for (int kc = 0; kc < 4; ++kc) qf[kc] = ld8(qp + kc * 16);
    f32x16 o0, o1;
#pragma unroll
    for (int i = 0; i < 16; ++i) { o0[i] = 0.f; o1[i] = 0.f; }
    float m = -1e30f, l = 0.f;
    const float sc = 0.125f * LOG2E;
    __syncthreads();
    for (int j = 0; j < 5; ++j) {
        const int r0 = 32 * wave + 32 * j, kt0 = kbase + r0;
        if (kt0 + 31 < 0) continue;
        const LAS unsigned char* kb = lds + (r0 + c) * KC_STR + hi * 16;
        f32x16 s;
#pragma unroll
        for (int i = 0; i < 16; ++i) s[i] = 0.f;
#pragma unroll
        for (int kc = 0; kc < 4; ++kc) s = MFMA32(*(const LAS s16x8*)(kb + kc * 32), qf[kc], s);
        const LAS unsigned char* vb = lds + KA_BYTES + c * VA_STR + r0 * 2 + 8 * hi;
        const s16x8 v00 = ldv_lds(vb), v01 = ldv_lds(vb + 32), v10 = ldv_lds(vb + 32 * VA_STR), v11 = ldv_lds(vb + 32 * VA_STR + 32);
        float p[16];
        if (FAST) {
            float ps0 = 0.f, ps1 = 0.f;
#pragma unroll
            for (int i = 0; i < 16; ++i) {
                const int uk = kt0 + 8 * (i >> 2) + 4 * hi + (i & 3), dist = uq - uk;
                const bool valid = (dist >= 0) && (dist <= 128) && (uk >= 0);
                p[i] = valid ? fexp2(s[i] * sc) : 0.f; if (i < 8) ps0 += p[i]; else ps1 += p[i];
            }
            l += ps0 + ps1; m = 0.f;
        } else {
            float mx = -1e30f; unsigned vmask = 0u;
#pragma unroll
            for (int i = 0; i < 16; ++i) {
                const int uk = kt0 + 8 * (i >> 2) + 4 * hi + (i & 3), dist = uq - uk;
                const bool valid = (dist >= 0) && (dist <= 128) && (uk >= 0);
                const float sv = valid ? s[i] * sc : -1e30f; p[i] = sv; mx = fmaxf(mx, sv); vmask |= valid ? (1u << i) : 0u;
            }
            mx = fmaxf(mx, lane_x32(mx, hi));
            const float mn = fmaxf(m, mx), alpha = fexp2(m - mn); m = mn;
            float ps = 0.f;
#pragma unroll
            for (int i = 0; i < 16; ++i) { p[i] = ((vmask >> i) & 1u) ? fexp2(p[i] - mn) : 0.f; ps += p[i]; }
            l = l * alpha + ps;
#pragma unroll
            for (int i = 0; i < 16; ++i) { o0[i] *= alpha; o1[i] *= alpha; }
        }
        const s16x8 pf0 = packp(p), pf1 = packp(p + 8);
        o0 = MFMA32(v00, pf0, o0); o0 = MFMA32(v01, pf1, o0);
        o1 = MFMA32(v10, pf0, o1); o1 = MFMA32(v11, pf1, o1);
    }
    l += __shfl_xor(l, 32);
    store_o(OG + (tb + tq) * 768 + head * 64, o0, o1, 1.f / l, hi);
    if (hi == 0) LSE[(tb + tq) * 12 + head] = m + flog2(l);
}
__device__ __forceinline__ void combine_A(const bf16_t* OG, const float* LSE, bf16_t* OA, int gw, int NGW, int lane) {
    const int slot = lane >> 4, d4 = (lane & 15) * 4;
    float cl[3], nl[3]; u32x2 co[3], no[3];
#define CA_LOAD(t, L_, O_) do { _Pragma("unroll") for (int g = 0; g < 3; ++g) { L_[g] = LSE[(size_t)(t) * 12 + 4 * g + slot]; O_[g] = *(const u32x2*)(OG + (size_t)(t) * 768 + g * 256 + slot * 64 + d4); } } while (0)
    if (gw < TC) CA_LOAD(gw, cl, co);
    for (int t = gw; t < TC; t += NGW) {
        if (t + NGW < TC) CA_LOAD(t + NGW, nl, no);
        const float mx = fmaxf(cl[0], fmaxf(cl[1], cl[2]));
        const float w0 = fexp2(cl[0] - mx), w1 = fexp2(cl[1] - mx), w2 = fexp2(cl[2] - mx), inv = 1.f / (w0 + w1 + w2);
        const u32x2 a = co[0], b = co[1], cc = co[2];
        float r[4];
        r[0] = (w0 * __builtin_bit_cast(float, a.x << 16) + w1 * __builtin_bit_cast(float, b.x << 16) + w2 * __builtin_bit_cast(float, cc.x << 16)) * inv;
        r[1] = (w0 * __builtin_bit_cast(float, a.x & 0xffff0000u) + w1 * __builtin_bit_cast(float, b.x & 0xffff0000u) + w2 * __builtin_bit_cast(float, cc.x & 0xffff0000u)) * inv;
        r[2] = (w0 * __builtin_bit_cast(float, a.y << 16) + w1 * __builtin_bit_cast(float, b.y << 16) + w2 * __builtin_bit_cast(float, cc.y << 16)) * inv;
        r[3] = (w0 * __builtin_bit_cast(float, a.y & 0xffff0000u) + w1 * __builtin_bit_cast(float, b.y & 0xffff0000u) + w2 * __builtin_bit_cast(float, cc.y & 0xffff0000u)) * inv;
        u32x2 w; w.x = cvtpk(r[0], r[1]); w.y = cvtpk(r[2], r[3]);
        *(u32x2*)(OA + (size_t)t * 1280 + slot * 64 + d4) = w;
#pragma unroll
        for (int g = 0; g < 3; ++g) { cl[g] = nl[g]; co[g] = no[g]; }
    }
#undef CA_LOAD
}
__device__ __forceinline__ void attn_A(const bf16_t* AQ, const bf16_t* AK, const bf16_t* AVt, bf16_t* OA, int bl, int slot, int r, int ut, int lane) {
    const int c = lane & 31, hi = lane >> 5;
    const size_t tb = (size_t)bl * SEQ;
    const int tq = 16 * (32 * ut + c) + r;
    f32x16 o0, o1;
#pragma unroll
    for (int i = 0; i < 16; ++i) { o0[i] = 0.f; o1[i] = 0.f; }
    float m = -1e30f, l = 0.f;
    const float sc = 0.125f * LOG2E;
#pragma unroll
    for (int g = 0; g < 3; ++g) {
        const int d = g == 0 ? 1 : (g == 1 ? 4 : 16), L = SEQ / d, qs = 16 / d;
        const int rc = r % d, uq0 = (512 * ut + r) / d, uq = uq0 + c * qs, head = g * 4 + slot;
        const bf16_t* qp = AQ + (tb + tq) * 768 + head * 64 + hi * 8;
        s16x8 qf[4];
#pragma unroll
        for (int kc = 0; kc < 4; ++kc) qf[kc] = ld8(qp + kc * 16);
        const int klo = (uq0 > 128 ? uq0 - 128 : 0) & ~31, khi = uq0 + 31 * qs;
        const bf16_t* vbase = AVt + (size_t)(head * 64 + c) * TC + tb + (size_t)rc * L + 4 * hi;
        for (int k0 = klo; k0 <= khi; k0 += 32) {
            const bf16_t* kp = AK + (tb + (size_t)(k0 + c) * d + rc) * 768 + head * 64 + hi * 8;
            f32x16 s;
#pragma unroll
            for (int i = 0; i < 16; ++i) s[i] = 0.f;
#pragma unroll
            for (int kc = 0; kc < 4; ++kc) s = MFMA32(ld8(kp + kc * 16), qf[kc], s);
            const s16x8 v00 = ldv(vbase + k0), v01 = ldv(vbase + k0 + 16), v10 = ldv(vbase + (size_t)32 * TC + k0), v11 = ldv(vbase + (size_t)32 * TC + k0 + 16);
            float p[16]; float mx = -1e30f; unsigned vmask = 0u;
#pragma unroll
            for (int i = 0; i < 16; ++i) {
                const int uk = k0 + 8 * (i >> 2) + 4 * hi + (i & 3), dist = uq - uk;
                const bool valid = (dist >= 0) && (dist <= 128);
                const float sv = valid ? s[i] * sc : -1e30f; p[i] = sv; mx = fmaxf(mx, sv); vmask |= valid ? (1u << i) : 0u;
            }
            mx = fmaxf(mx, __shfl_xor(mx, 32));
            const float mn = fmaxf(m, mx), alpha = fexp2(m - mn); m = mn;
            float ps = 0.f;
#pragma unroll
            for (int i = 0; i < 16; ++i) { p[i] = ((vmask >> i) & 1u) ? fexp2(p[i] - mn) : 0.f; ps += p[i]; }
            l = l * alpha + ps;
#pragma unroll
            for (int i = 0; i < 16; ++i) { o0[i] *= alpha; o1[i] *= alpha; }
            const s16x8 pf0 = packp(p), pf1 = packp(p + 8);
            o0 = MFMA32(v00, pf0, o0); o0 = MFMA32(v01, pf1, o0);
            o1 = MFMA32(v10, pf0, o1); o1 = MFMA32(v11, pf1, o1);
        }
    }
    l += __shfl_xor(l, 32);
    store_o(OA + (tb + tq) * 256 + slot * 64, o0, o1, 1.f / l, hi);
}

#define XB_TMO      128
#define XB_XCNT(j)  (256  + 64 * (j))
#define XB_XSUB(j)  (1280 + 64 * (j))
#define XB_XGEN(j)  (2304 + 64 * (j))
#define XB_TOP      3328
#define XB_TOPGEN   3392
#define XCD_BAR_WORDS 3456
#define XB_SPIN_CAP (1u << 18)

__device__ __forceinline__ unsigned xb_ld(unsigned* p)              { return __hip_atomic_load(p, __ATOMIC_RELAXED, __HIP_MEMORY_SCOPE_AGENT); }
__device__ __forceinline__ unsigned xb_add(unsigned* p, unsigned v) { return __hip_atomic_fetch_add(p, v, __ATOMIC_RELAXED, __HIP_MEMORY_SCOPE_AGENT); }
__device__ __forceinline__ unsigned xb_xcc_id() { return (unsigned)__builtin_amdgcn_s_getreg((3 << 11) | 20) & 0xFu; }
#define XB_SPIN(cond, bar) do { unsigned _sp = 0; while (cond) { __builtin_amdgcn_s_sleep(1); \
    if ((++_sp & 255u) == 0u) { if (xb_ld(&(bar)[XB_TMO])) break; if (_sp > XB_SPIN_CAP) { atomicAdd(&(bar)[XB_TMO], 1u); break; } } } } while (0)

struct XcdBarrier {
    unsigned* bar; unsigned x;
    volatile LAS unsigned* st;
};

__device__ __forceinline__ XcdBarrier xcd_barrier_post(unsigned* bar, volatile LAS unsigned* st) {
    XcdBarrier b; b.bar = bar; b.x = xb_xcc_id(); b.st = st;
    if (threadIdx.x == 0) (void)xb_add(&bar[XB_XCNT(b.x)], 1u);
    return b;
}
__device__ __forceinline__ void xcd_barrier_complete(unsigned* bar, unsigned x, unsigned& nloc, unsigned& nx) {
    const unsigned G = gridDim.x * gridDim.y * gridDim.z;
    unsigned sum, cnt, mine, sp = 0u;
    for (;;) {
        sum = 0u; cnt = 0u; mine = 0u;
#pragma unroll
        for (unsigned j = 0; j < 16; ++j) { const unsigned c = xb_ld(&bar[XB_XCNT(j)]); sum += c; cnt += (c > 0u) ? 1u : 0u; mine = (j == x) ? c : mine; }
        if (sum == G) break;
        __builtin_amdgcn_s_sleep(1);
        if ((++sp & 255u) == 0u) { if (xb_ld(&bar[XB_TMO])) break; if (sp > XB_SPIN_CAP) { atomicAdd(&bar[XB_TMO], 1u); break; } }
    }
    nloc = mine > 0u ? mine : 1u; nx = cnt > 0u ? cnt : 1u;
}

__device__ __forceinline__ void xcd_barrier(const XcdBarrier& b) {
    asm volatile("s_waitcnt vmcnt(0)" ::: "memory");
    __syncthreads();
    if (threadIdx.x == 0) {
        unsigned* bar = b.bar;
        __builtin_amdgcn_s_waitcnt(0);
        unsigned nloc = b.st[0], nx = b.st[1];
        if (nloc == 0u) { xcd_barrier_complete(bar, b.x, nloc, nx); b.st[0] = nloc; b.st[1] = nx; }
        const unsigned old = xb_add(&bar[XB_XSUB(b.x)], 1u);
        const unsigned gen = old / nloc;
        if (old + 1u == (gen + 1u) * nloc) {
            __builtin_amdgcn_fence(__ATOMIC_RELEASE, "agent");
            asm volatile("s_waitcnt vmcnt(0)" ::: "memory");
            const unsigned og = xb_add(&bar[XB_TOP], 1u);
            const unsigned tg = og / nx;
            if (og + 1u == (tg + 1u) * nx) xb_add(&bar[XB_TOPGEN], 1u);
            else XB_SPIN(xb_ld(&bar[XB_TOPGEN]) == tg, bar);
            __builtin_amdgcn_fence(__ATOMIC_ACQUIRE, "agent");
            xb_add(&bar[XB_XGEN(b.x)], 1u);
            asm volatile("s_waitcnt vmcnt(0)" ::: "memory");
        } else {
            XB_SPIN(xb_ld(&bar[XB_XGEN(b.x)]) == gen, bar);
            __builtin_amdgcn_fence(__ATOMIC_ACQUIRE, "agent");
            asm volatile("s_waitcnt vmcnt(0)" ::: "memory");
        }
    }
    __syncthreads();
}

#ifndef PHMASK
#define PHMASK 0xFFFF
#endif
#define PH(k) if constexpr ((PHMASK >> (k)) & 1)
__global__ void __launch_bounds__(512, 2) mega_fwd(Args a) {
    extern __shared__ __attribute__((aligned(16))) unsigned char lds_raw[];
    LAS unsigned char* lds = (LAS unsigned char*)lds_raw;
    volatile LAS unsigned* shq = (volatile LAS unsigned*)(lds + 131072);
    cg::grid_group grid = cg::this_grid();
    if (threadIdx.x < 2) ((volatile LAS unsigned*)(lds + 131072 + 256))[threadIdx.x] = 0u;
    __syncthreads();
    const int tid = threadIdx.x, lane = tid & 63, wave = __builtin_amdgcn_readfirstlane(tid >> 6);
    const int G = (int)gridDim.x, gw = (int)blockIdx.x * 8 + wave, NGW = G * 8;
    unsigned char* ws = a.ws;
    unsigned* ctr = (unsigned*)(ws + O_CTL);
    f32x2* tabA = (f32x2*)(ws + O_TABA); f32x2* tabM = (f32x2*)(ws + O_TABM);

    {
        LAS float* scr = (LAS float*)(lds + wave * 16384);
        unsigned ib = 0u;
        for (int l = 0; l < DEPTH; ++l) {
            const float* win = a.in[2] + (size_t)l * 1024 * INC; bf16_t* wt = (bf16_t*)(ws + O_WIN + l * S_WIN);
            for (int hb = 0; hb < 48; ++hb) {
                const int isk = hb >= 24, hd = (hb % 24) >> 1, bj = hb & 1;
                tr_seg(win, INC, 1024, isk * 768 + hd * 64 + 32 * bj, 32, wt, isk * 768 + (hd >> 2) * 256 + 128 * bj + 32 * (hd & 3), scr, gw, NGW, lane, ib);
            }
            tr_seg(win, INC, 1024, 2304, 256, wt, 1536, scr, gw, NGW, lane, ib);
            tr_seg(win, INC, 1024, 2560, 160, wt, 1792, scr, gw, NGW, lane, ib);
            tr_seg(win, INC, 1024, 2720, 512, wt, 2048, scr, gw, NGW, lane, ib);
            tr_seg(win, INC, 1024, 3232, 512, wt, 2560, scr, gw, NGW, lane, ib);
            tr_seg(win, INC, 1024, 4256, 3072, wt, 3072, scr, gw, NGW, lane, ib);
            tr_seg(win, INC, 1024, 1536, 768, wt, 6144, scr, gw, NGW, lane, ib);
            tr_seg(win, INC, 1024, 3744, 512, wt, 6912, scr, gw, NGW, lane, ib);
            tr_seg(a.in[6] + (size_t)l * 256 * 768, 768, 256, 0, 768, (bf16_t*)(ws + O_WQB + l * S_WQB), 0, scr, gw, NGW, lane, ib, a.in[5] + l * 256);
            for (int h = 0; h < 8; ++h) {
                tr_seg(a.in[8] + (size_t)l * 128 * 1024, 1024, 128, h * 128, 64, (bf16_t*)(ws + O_WKVB + l * S_WKVB), h * 64, scr, gw, NGW, lane, ib, a.in[7] + l * 128);
                tr_seg(a.in[8] + (size_t)l * 128 * 1024, 1024, 128, h * 128 + 64, 64, (bf16_t*)(ws + O_WKVB + l * S_WKVB), 512 + h * 64, scr, gw, NGW, lane, ib, a.in[7] + l * 128);
            }
            const float* wb = a.in[11] + (size_t)l * 1280 * 1024;
            { bf16_t* wbt = (bf16_t*)(ws + O_WBRA + l * S_WBR);
              tr_seg(wb, 1024, 256, 0, 1024, wbt, 0, scr, gw, NGW, lane, ib, nullptr, 1280, 0);
              tr_seg(wb + (size_t)256 * 1024, 1024, 512, 0, 1024, wbt, 0, scr, gw, NGW, lane, ib, nullptr, 1280, 256);
              tr_seg(wb + (size_t)768 * 1024, 1024, 512, 0, 1024, wbt, 0, scr, gw, NGW, lane, ib, nullptr, 1280, 768); }
            tr_seg(a.in[12] + (size_t)l * 1024 * 1024, 1024, 1024, 0, 1024, (bf16_t*)(ws + O_WOUT + l * S_WOUT), 0, scr, gw, NGW, lane, ib);
            tr_seg(a.in[14] + (size_t)l * 1024 * 4096, 4096, 1024, 0, 4096, (bf16_t*)(ws + O_W1 + l * S_W1), 0, scr, gw, NGW, lane, ib);
            tr_seg(a.in[15] + (size_t)l * 4096 * 1024, 1024, 4096, 0, 1024, (bf16_t*)(ws + O_W2 + l * S_W1), 0, scr, gw, NGW, lane, ib);
        }
        {   volatile LAS float* fq = (volatile LAS float*)(lds + 131072 + 64);
            if (tid == 0) {
#pragma unroll
                for (int j = 0; j < 8; ++j) fq[j] = a.invfA[j];
#pragma unroll
                for (int j = 0; j < 16; ++j) fq[8 + j] = a.invfM[j];
            }
            __syncthreads();
        }
        for (int i = (int)blockIdx.x * 512 + tid; i < SEQ * 24; i += G * 512) {
            const int s = i / 24, j = i % 24;
            const float invf = ((volatile LAS float*)(lds + 131072 + 64))[j];
            const float ang = (float)s * invf;
            const double rev = (double)ang * 0.15915494309189535;
            const float fr = (float)(rev - __builtin_floor(rev));
            f32x2 cs; cs[0] = __builtin_amdgcn_cosf(fr); cs[1] = __builtin_amdgcn_sinf(fr);
            if (j < 8) tabA[s * 8 + j] = cs; else tabM[s * 16 + (j - 8)] = cs;
        }
        if (blockIdx.x == 0) { if (tid < 256) ctr[tid] = 0u; unsigned* bw = (unsigned*)(ws + O_BAR); for (int i = tid; i < XCD_BAR_WORDS; i += 512) bw[i] = 0u; }
    }
    grid.sync();
    const XcdBarrier xbar = xcd_barrier_post((unsigned*)(ws + O_BAR), (volatile LAS unsigned*)(lds + 131072 + 256));

#define GAS __attribute__((address_space(1)))
#define INP(k) ({ uintptr_t _p = (uintptr_t)a.in[k]; asm volatile("" : "+s"(_p)); (const float*)(const GAS float*)_p; })
#ifdef PROBE_MASK
    constexpr int NST = 14 + __builtin_popcount(PROBE_MASK);
#else
    constexpr int NST = 14;
#endif
    for (int step = 0; step < NCHUNK * DEPTH * NST; ++step) {
        const int inst = step / NST, l = inst & (DEPTH - 1), ch = inst / DEPTH;
        int ri = step - inst * NST, rep = 0;
#ifdef PROBE_MASK
        {   int k = 0, found = 0;
#pragma unroll
            for (int sx = 0; sx < 14; ++sx) { if (k == ri) { found = sx; rep = 0; } ++k; if ((PROBE_MASK >> sx) & 1) { if (k == ri) { found = sx; rep = 1; } ++k; } }
            ri = found; }
#endif
        const int st = ri <= 2 ? ri : (ri <= 7 ? ri + 1 : (ri == 8 ? 16 : (ri == 9 ? 9 : ri + 2)));
        const size_t tok0 = (size_t)ch * TC;
        uintptr_t wsi = (uintptr_t)a.ws; asm volatile("" : "+s"(wsi));
        unsigned char* wsl = (unsigned char*)(GAS unsigned char*)wsi;
        uintptr_t outi = (uintptr_t)a.out; asm volatile("" : "+s"(outi));
        float* outl = (float*)(GAS float*)outi;
        int tidl = tid; asm volatile("" : "+v"(tidl));
        const int lanel = tidl & 63;
        int wavel = wave; asm volatile("" : "+s"(wavel));
        const int gwl = (int)blockIdx.x * 8 + wavel;
        const float* xsrc = (l == 0 ? INP(0) : (const float*)outl) + tok0 * 1024;
        float* xdst = outl + tok0 * 1024;
        bool sync = true;
        const bool is_gemm = (st == 1 || st == 2 || st == 4 || st == 5 || st == 6 || st == 9 || st == 12 || st == 14 || st == 15);
        if (is_gemm) {
            const bf16_t* A; const bf16_t* Bt; int M, N, K; EpiDyn E{wsl, M_RES, xdst, xdst, nullptr, nullptr};
            const bf16_t* win = (const bf16_t*)(wsl + O_WIN + l * S_WIN);
            const bf16_t* wkvb = (const bf16_t*)(wsl + O_WKVB + l * S_WKVB);
            switch (st) {
            case 1: A = (const bf16_t*)(wsl + O_XN); Bt = win; M = TC; N = NPROJ; K = 1024; E.mode = M_PROJ; E.g0 = INP(3) + l * 64; E.g1 = INP(4) + l * 64; sync = false; break;
            case 2: A = win + (size_t)NPROJ * 1024; Bt = (const bf16_t*)(wsl + O_XN); M = NSWV; N = TC; K = 1024; E.mode = M_SWAPV; break;
            case 4: A = (const bf16_t*)(wsl + O_BQL); Bt = (const bf16_t*)(wsl + O_WQB + l * S_WQB); M = TC; N = 768; K = 256; E.mode = M_BQ; sync = false; break;
            case 5: A = (const bf16_t*)(wsl + O_KVAN); Bt = wkvb; M = TC; N = 512; K = 128; E.mode = M_BKN; sync = false; break;
            case 6: A = wkvb + (size_t)512 * 128; Bt = (const bf16_t*)(wsl + O_KVAN); M = 512; N = TC; K = 128; E.mode = M_BVT; break;
            case 9: A = (const bf16_t*)(wsl + O_OA); Bt = (const bf16_t*)(wsl + O_WBRA + l * S_WBR); M = TC; N = 1024; K = 1280; E.mode = M_GCAT; break;
            case 12: A = (const bf16_t*)(wsl + O_XN); Bt = (const bf16_t*)(wsl + O_WOUT + l * S_WOUT); M = TC; N = 1024; K = 1024; E.mode = M_RES; E.rbase = xsrc; break;
            case 14: A = (const bf16_t*)(wsl + O_XN); Bt = (const bf16_t*)(wsl + O_W1 + l * S_W1); M = TC; N = 4096; K = 1024; E.mode = M_U; break;
            default: A = (const bf16_t*)(wsl + O_U); Bt = (const bf16_t*)(wsl + O_W2 + l * S_W1); M = TC; N = 1024; K = 4096; E.mode = M_RES; break;
            }
            pg8::Gemm g{A, Bt, M, N, K, (E.mode == M_SWAPV) ? 1 : 0}; pg8::StaticOrder S; S.init(M, N, G, (int)blockIdx.x);
            pg8::gemm_phase<EpiDyn, pg8::StaticOrder, true, true>(lds, g, S, E, tidl);
        } else if (st == 0) {
            rms_rows(xsrc, INP(1) + l * 1024, (bf16_t*)(wsl + O_XN), TC, gwl, NGW, lanel);
        } else if (st == 13) {
            rms_rows(xdst, INP(13) + l * 1024, (bf16_t*)(wsl + O_XN), TC, gwl, NGW, lanel);
        } else if (st == 7) {
            post_mla((bf16_t*)(wsl + O_BQ), (const bf16_t*)(wsl + O_BKN), (const bf16_t*)(wsl + O_KR), (bf16_t*)(wsl + O_BK), INP(9) + l * 96, INP(10) + l * 96, (const f32x2*)(wsl + O_TABM), gwl, NGW, lanel);
        } else if (st == 16) {
            combine_A((const bf16_t*)(wsl + O_OG), (const float*)(wsl + O_LSE), (bf16_t*)(wsl + O_OA), gwl, NGW, lanel);
        } else {
            unsigned* q = (unsigned*)(wsl + O_CTL) + (ch * DEPTH + l) * 8 + rep * 64;
            const int x0 = (int)(__builtin_amdgcn_s_getreg((3 << 11) | 20) & 7u);
            bool fastA;
            {
                const float* gqa_ = INP(3) + l * 64; const float* gka_ = INP(4) + l * 64;
                float ga = fabsf(gqa_[lanel]), gb = fabsf(gka_[lanel]);
#pragma unroll
                for (int o = 32; o >= 1; o >>= 1) { ga = fmaxf(ga, __shfl_xor(ga, o)); gb = fmaxf(gb, __shfl_xor(gb, o)); }
                fastA = __builtin_amdgcn_readfirstlane(__builtin_bit_cast(int, ga * gb * (64.f * 0.125f * LOG2E))) <= __builtin_bit_cast(int, 100.f);
            }
            bool fastB;
            {
                const float* gq = INP(9) + l * 96; const float* gk = INP(10) + l * 96;
                float a = fmaxf(fabsf(gq[lanel]), lanel < 32 ? fabsf(gq[64 + lanel]) : 0.f), b = fmaxf(fabsf(gk[lanel]), lanel < 32 ? fabsf(gk[64 + lanel]) : 0.f);
#pragma unroll
                for (int o = 32; o >= 1; o >>= 1) { a = fmaxf(a, __shfl_xor(a, o)); b = fmaxf(b, __shfl_xor(b, o)); }
                fastB = __builtin_amdgcn_readfirstlane(__builtin_bit_cast(int, a * b * (96.f * 0.10206207261596575f * LOG2E))) <= __builtin_bit_cast(int, 100.f);
            }
            for (int qi = 0; qi < 8; ++qi) {
                const int x = (x0 + qi) & 7;
                unsigned nxt = 0u;
                if (tidl == 0) nxt = atomicAdd(q + x, 1u);
                for (;;) {
                    __syncthreads();
                    if (tidl == 0) shq[0] = nxt;
                    __syncthreads();
                    const int idx = (int)shq[0];
                    if (idx >= CB * 56) break;
                    if (tidl == 0) nxt = atomicAdd(q + x, 1u);
#ifdef PROBE_KIND
                    if (rep == 1 && ((idx < CB * 16) ? 0 : (idx < CB * 40 ? 1 : 2)) != PROBE_KIND) continue;
#endif
                    int tidi = tidl; asm volatile("" : "+v"(tidi));
                    const int lanei = tidi & 63;
                    if (idx < CB * 16) { const int bh = x + 8 * (idx >> 4), sq = 15 - (idx & 15);
                        if (fastB) attn_B_blk2<true>((const bf16_t*)(wsl + O_BQ), (const bf16_t*)(wsl + O_BK), (const bf16_t*)(wsl + O_BVT), (bf16_t*)(wsl + O_OA) + 256, bh >> 3, bh & 7, sq, lds, tidi, lanei, wavel);
                        else attn_B_blk((const bf16_t*)(wsl + O_BQ), (const bf16_t*)(wsl + O_BK), (const bf16_t*)(wsl + O_BVT), (bf16_t*)(wsl + O_OA) + 256, bh >> 3, bh & 7, sq, lds, tidi, lanei, wavel, 1.f); }
                    else if (idx < CB * 40) { const int i2 = idx - CB * 16, pr = x + 8 * (i2 >> 4), i16 = i2 & 15, bl = pr / 12, head = pr - bl * 12, g2 = (head >> 2) * 2;
                        if (fastA) attn_A_blk<true>((const bf16_t*)(wsl + O_AQ), (const bf16_t*)(wsl + O_AK), (const bf16_t*)(wsl + O_AVT), (bf16_t*)(wsl + O_OG), (float*)(wsl + O_LSE), bl, head, i16 & ((1 << g2) - 1), i16 >> g2, lds, tidi, lanei, wavel);
                        else attn_A_blk<false>((const bf16_t*)(wsl + O_AQ), (const bf16_t*)(wsl + O_AK), (const bf16_t*)(wsl + O_AVT), (bf16_t*)(wsl + O_OG), (float*)(wsl + O_LSE), bl, head, i16 & ((1 << g2) - 1), i16 >> g2, lds, tidi, lanei, wavel); }
                    else { const int i2 = idx - CB * 40, bh = x + 8 * (i2 >> 4), sq = 15 - (i2 & 15);
                        attn_C_blk((const bf16_t*)(wsl + O_CQ), (const bf16_t*)(wsl + O_CK), (const bf16_t*)(wsl + O_CVT), (bf16_t*)(wsl + O_OA) + 768, bh >> 3, bh & 7, sq, lds, tidi, lanei, wavel); }
                }
            }
        }
        if (sync) xcd_barrier(xbar);
    }
}

extern "C" void kernel_launch(void* const* d_in, const int* in_sizes, int n_in, void* d_out, int out_size, void* d_ws, size_t ws_size, hipStream_t stream) {
    static int grid = 0;
    if (grid == 0) {
        if (n_in != 16 || ws_size < WS_END) { fprintf(stderr, "kernel_launch: need 16 inputs and %zu bytes of workspace; got %d, %zu\n", (size_t)WS_END, n_in, ws_size); grid = -1; return; }
        int dev = 0, cus = 0, per_cu = 0;
        hipGetDevice(&dev); hipDeviceGetAttribute(&cus, hipDeviceAttributeMultiprocessorCount, dev);
        if (hipFuncSetAttribute((const void*)mega_fwd, hipFuncAttributeMaxDynamicSharedMemorySize, LDS_BYTES) != hipSuccess) { fprintf(stderr, "kernel_launch: hipFuncSetAttribute failed\n"); grid = -1; return; }
        if (hipOccupancyMaxActiveBlocksPerMultiprocessor(&per_cu, (const void*)mega_fwd, 512, LDS_BYTES) != hipSuccess || per_cu < 1) { fprintf(stderr, "kernel_launch: occupancy query says %d blocks per CU\n", per_cu); per_cu = 1; }
        (void)hipGetLastError();
        grid = cus > 0 ? cus : 256;
    }
    if (grid < 0) return;
    Args a{};
    for (int i = 0; i < 16; ++i) a.in[i] = (const float*)d_in[i];
    a.out = (float*)d_out; a.ws = (unsigned char*)d_ws;
    for (int i = 0; i < 8; ++i) a.invfA[i] = (float)pow(500000.0, -(double)i / 8.0);
    for (int i = 0; i < 16; ++i) a.invfM[i] = (float)pow(500000.0, -(double)i / 16.0);
    void* args[] = {&a};
    hipError_t e = hipLaunchCooperativeKernel((const void*)mega_fwd, dim3(grid), dim3(512), args, LDS_BYTES, stream);
    if (e != hipSuccess) fprintf(stderr, "kernel_launch: cooperative launch failed: %s (grid %d)\n", hipGetErrorString(e), grid);
}
```
